# Optimizing an MI355X kernel written in HIP

```python
import math
import jax, jax.numpy as jnp
from jax import lax
import numpy as np

D_MODEL = 1024
BATCH = 16
SEQ = 4096
DEPTH = 2

N_MIXERS = 2
N_SUB = 3
D_FF = 2816
MLSTM_HEADS = 8
MLSTM_DQK = D_MODEL // (2 * MLSTM_HEADS)
MLSTM_DV = D_MODEL // MLSTM_HEADS
MLSTM_CHUNK = 64
CONV_WIDTH = 4
MLSTM_QK_COLS = 2 * MLSTM_HEADS * MLSTM_DQK
MLSTM_V_COLS = MLSTM_HEADS * MLSTM_DV
MLSTM_PROJ = MLSTM_QK_COLS + 2 * MLSTM_V_COLS + 2 * MLSTM_HEADS
DIL_GROUPS = ((128, 1), (512, 4), (2048, 16))
N_GROUPS = len(DIL_GROUPS)
ATTN_HEADS = 8
ATTN_HEAD_DIM = D_MODEL // ATTN_HEADS
ATTN_PROJ = N_GROUPS * 3 * ATTN_HEADS * ATTN_HEAD_DIM
ALPHA = (2 * DEPTH) ** 0.25
BETA = (8 * DEPTH) ** -0.25
LN_EPS = 1e-5
RMS_EPS = 1e-6
N_MLSTM_LAYERS = (DEPTH + 1) // 2
N_ATTN_LAYERS = DEPTH // 2

kernel_name = 'hybrid_mlstm_dilated_attn_macaron_deepnorm_adaln'


def _layer_norm(x, g, b):
    xf = x.astype(jnp.float32)
    mu = xf.mean(-1, keepdims=True)
    var = jnp.square(xf - mu).mean(-1, keepdims=True)
    return ((xf - mu) * lax.rsqrt(var + LN_EPS) * g.astype(jnp.float32) + b.astype(jnp.float32)).astype(x.dtype)


def _swiglu(h, w_in, w_out):
    g, u = jnp.split(h @ w_in, 2, axis=-1)
    return (jax.nn.silu(g) * u) @ w_out


def _causal_dwconv(x, w):
    k_w, ch = w.shape
    xp = jnp.pad(x, ((0, 0), (k_w - 1, 0), (0, 0)))
    return lax.conv_general_dilated(xp, w[:, None, :].astype(x.dtype), window_strides=(1,), padding='VALID',
                                    dimension_numbers=('NWC', 'WIO', 'NWC'), feature_group_count=ch)


def _mlstm_cell_chunkwise(q, k, v, i_pre, log_f):
    B, S, H, DK = q.shape
    DV = v.shape[-1]
    L = MLSTM_CHUNK
    nc = S // L

    def chunks(t):
        return jnp.moveaxis(t.reshape((B, nc, L, H) + t.shape[3:]), 3, 1)

    qc = chunks(q.astype(jnp.float32)) * (DK ** -0.5)
    kc = chunks(k.astype(jnp.float32))
    vc = chunks(v.astype(jnp.float32))
    ig = chunks(i_pre)
    bcum = jnp.cumsum(chunks(log_f), axis=-1)
    b_last = bcum[..., -1]

    a = b_last[..., None] - bcum + ig
    m_loc = a.max(-1)
    wa = jnp.exp(a - m_loc[..., None])
    c_loc = jnp.einsum('bhcl,bhclv,bhclk->bhcvk', wa, vc, kc)
    n_loc = jnp.einsum('bhcl,bhclk->bhck', wa, kc)

    def step(carry, inp):
        c_st, n_st, m_st = carry
        cl, nl, ml, bl = inp
        m_new = jnp.maximum(bl + m_st, ml)
        sp = jnp.exp(bl + m_st - m_new)
        sl = jnp.exp(ml - m_new)
        c_new = sp[..., None, None] * c_st + sl[..., None, None] * cl
        n_new = sp[..., None] * n_st + sl[..., None] * nl
        return (c_new, n_new, m_new), (c_st, n_st, m_st)

    init = (jnp.zeros((B, H, DV, DK), jnp.float32), jnp.zeros((B, H, DK), jnp.float32),
            jnp.zeros((B, H), jnp.float32))
    xs = (jnp.moveaxis(c_loc, 2, 0), jnp.moveaxis(n_loc, 2, 0), jnp.moveaxis(m_loc, 2, 0), jnp.moveaxis(b_last, 2, 0))
    _, (c_prev, n_prev, m_prev) = lax.scan(step, init, xs)
    c_prev = jnp.moveaxis(c_prev, 0, 2)
    n_prev = jnp.moveaxis(n_prev, 0, 2)
    m_prev = jnp.moveaxis(m_prev, 0, 2)

    causal = jnp.tril(jnp.ones((L, L), dtype=bool))
    dlog = jnp.where(causal, bcum[..., :, None] - bcum[..., None, :] + ig[..., None, :], -jnp.inf)
    inter_log = bcum + m_prev[..., None]
    m = jnp.maximum(inter_log, dlog.max(-1))
    sc = jnp.einsum('bhcik,bhcjk->bhcij', qc, kc) * jnp.exp(dlog - m[..., None])
    inter_w = jnp.exp(inter_log - m)
    num = jnp.einsum('bhcij,bhcjv->bhciv', sc, vc) + inter_w[..., None] * jnp.einsum('bhcik,bhcvk->bhciv', qc, c_prev)
    den = sc.sum(-1) + inter_w * jnp.einsum('bhcik,bhck->bhci', qc, n_prev)
    h = num / jnp.maximum(jnp.abs(den), jnp.exp(-m))[..., None]
    return jnp.moveaxis(h, 1, 3).reshape(B, S, H, DV)


def _mlstm_mixer(h, w_in, gate_bias, conv_w, head_gain, w_out):
    B, S, _ = h.shape
    proj = h @ w_in
    qk = proj[..., :MLSTM_QK_COLS]
    v = proj[..., MLSTM_QK_COLS:MLSTM_QK_COLS + MLSTM_V_COLS]
    o = proj[..., MLSTM_QK_COLS + MLSTM_V_COLS:MLSTM_QK_COLS + 2 * MLSTM_V_COLS]
    gates = proj[..., MLSTM_QK_COLS + 2 * MLSTM_V_COLS:].astype(jnp.float32) + gate_bias.astype(jnp.float32)
    qk = jax.nn.silu(_causal_dwconv(qk, conv_w))
    q = qk[..., :MLSTM_QK_COLS // 2].reshape(B, S, MLSTM_HEADS, MLSTM_DQK)
    k = qk[..., MLSTM_QK_COLS // 2:].reshape(B, S, MLSTM_HEADS, MLSTM_DQK)
    v = v.reshape(B, S, MLSTM_HEADS, MLSTM_DV)
    i_pre = gates[..., :MLSTM_HEADS]
    log_f = jax.nn.log_sigmoid(gates[..., MLSTM_HEADS:])
    ht = _mlstm_cell_chunkwise(q, k, v, i_pre, log_f)
    ht = ht * lax.rsqrt(jnp.mean(jnp.square(ht), axis=-1, keepdims=True) + RMS_EPS)
    ht = ht.reshape(B, S, MLSTM_V_COLS) * head_gain.astype(jnp.float32)
    y = jax.nn.sigmoid(o.astype(jnp.float32)) * ht
    return y.astype(h.dtype) @ w_out


def _dilated_window_attention(q, k, v, window, dilation):
    B, S, H, Dh = q.shape
    blk = window // dilation
    unit = blk * dilation
    s_pad = -(-S // unit) * unit
    nb = s_pad // unit

    def to_blocks(t):
        t = jnp.pad(t.astype(jnp.float32), ((0, 0), (0, s_pad - S), (0, 0), (0, 0)))
        t = jnp.swapaxes(t.reshape(B, s_pad // dilation, dilation, H, Dh), 1, 2)
        return t.reshape(B, dilation, nb, blk, H, Dh)

    def with_prev(t):
        prev = jnp.pad(t, ((0, 0), (0, 0), (1, 0), (0, 0), (0, 0), (0, 0)))[:, :, :-1]
        return jnp.concatenate([prev, t], axis=3)

    qb = to_blocks(q)
    kc = with_prev(to_blocks(k))
    vc = with_prev(to_blocks(v))
    s = jnp.einsum('brnqhd,brnkhd->brnhqk', qb, kc) * (Dh ** -0.5)
    qi = jnp.arange(blk)[:, None]
    ki = jnp.arange(2 * blk)[None, :]
    band = (ki >= qi) & (ki <= qi + blk)
    has_prev = (jnp.arange(nb) > 0)[:, None, None] | (ki >= blk)[None]
    mask = band[None] & has_prev
    s = jnp.where(mask[:, None], s, -jnp.inf)
    mx = s.max(-1, keepdims=True)
    e = jnp.exp(s - mx)
    den = e.sum(-1)
    o = jnp.einsum('brnhqk,brnkhd->brnqhd', e, vc) / jnp.swapaxes(den, 3, 4)[..., None]
    lse = jnp.swapaxes(mx[..., 0] + jnp.log(den), 3, 4)

    def from_blocks(t):
        t = t.reshape((B, dilation, s_pad // dilation) + t.shape[4:])
        t = jnp.swapaxes(t, 1, 2).reshape((B, s_pad) + t.shape[3:])
        return t[:, :S]

    return from_blocks(o), from_blocks(lse)


def _dilated_mixer(h, w_in, w_out):
    B, S, _ = h.shape
    proj = (h @ w_in).reshape(B, S, N_GROUPS, 3, ATTN_HEADS, ATTN_HEAD_DIM)
    outs, lses = [], []
    for g, (window, dilation) in enumerate(DIL_GROUPS):
        o_g, lse_g = _dilated_window_attention(proj[:, :, g, 0], proj[:, :, g, 1], proj[:, :, g, 2], window, dilation)
        outs.append(o_g)
        lses.append(lse_g)
    wts = jax.nn.softmax(jnp.stack(lses, 0), axis=0)
    o = jnp.sum(wts[..., None] * jnp.stack(outs, 0), axis=0)
    return o.reshape(B, S, ATTN_HEADS * ATTN_HEAD_DIM).astype(h.dtype) @ w_out


def _dense(key, fan_in, shape, scale=1.0):
    return jax.random.normal(key, shape, jnp.float32) * (scale * fan_in ** -0.5)


def setup_inputs(seed: int = 0) -> dict:
    key = jax.random.key(seed)
    ks = jax.random.split(key, 20)
    na, nb_ = N_MLSTM_LAYERS, N_ATTN_LAYERS
    x = jax.random.normal(ks[0], (BATCH, SEQ, D_MODEL), jnp.float32)
    c = jax.random.normal(ks[1], (BATCH, D_MODEL), jnp.float32)
    ada_w = _dense(ks[2], D_MODEL, (DEPTH, D_MODEL, N_SUB * 3 * D_MODEL), 0.1)
    ada_b = 0.01 * jax.random.normal(ks[3], (DEPTH, N_SUB * 3 * D_MODEL), jnp.float32)
    ln_g = 1.0 + 0.02 * jax.random.normal(ks[4], (DEPTH, N_SUB, D_MODEL), jnp.float32)
    ln_b = 0.02 * jax.random.normal(ks[5], (DEPTH, N_SUB, D_MODEL), jnp.float32)
    ffn_w_in = _dense(ks[6], D_MODEL, (DEPTH, 2, D_MODEL, 2 * D_FF))
    ffn_w_out = _dense(ks[7], D_FF, (DEPTH, 2, D_FF, D_MODEL), BETA)
    mlstm_w_in = jnp.concatenate([
        _dense(ks[8], D_MODEL, (na, D_MODEL, MLSTM_QK_COLS)),
        _dense(ks[9], D_MODEL, (na, D_MODEL, MLSTM_V_COLS), BETA),
        _dense(ks[10], D_MODEL, (na, D_MODEL, MLSTM_V_COLS + 2 * MLSTM_HEADS)),
    ], axis=-1)
    mlstm_gate_bias = jnp.concatenate([
        0.1 * jax.random.normal(ks[11], (na, MLSTM_HEADS), jnp.float32),
        3.0 + 3.0 * jax.random.uniform(ks[12], (na, MLSTM_HEADS), jnp.float32),
    ], axis=-1)
    mlstm_conv_w = _dense(ks[13], CONV_WIDTH, (na, CONV_WIDTH, MLSTM_QK_COLS))
    mlstm_head_gain = 1.0 + 0.02 * jax.random.normal(ks[14], (na, MLSTM_V_COLS), jnp.float32)
    mlstm_w_out = _dense(ks[15], MLSTM_V_COLS, (na, MLSTM_V_COLS, D_MODEL), BETA)
    qkv_scale = jnp.array([1.0, 1.0, BETA], jnp.float32)[:, None]
    attn_w_in = (_dense(ks[16], D_MODEL, (nb_, D_MODEL, N_GROUPS, 3, ATTN_HEADS * ATTN_HEAD_DIM)) * qkv_scale
                 ).reshape(nb_, D_MODEL, ATTN_PROJ)
    attn_w_out = _dense(ks[17], ATTN_HEADS * ATTN_HEAD_DIM, (nb_, ATTN_HEADS * ATTN_HEAD_DIM, D_MODEL), BETA)
    return {'x': x, 'c': c, 'ada_w': ada_w, 'ada_b': ada_b, 'ln_g': ln_g, 'ln_b': ln_b,
            'ffn_w_in': ffn_w_in, 'ffn_w_out': ffn_w_out, 'mlstm_w_in': mlstm_w_in,
            'mlstm_gate_bias': mlstm_gate_bias, 'mlstm_conv_w': mlstm_conv_w,
            'mlstm_head_gain': mlstm_head_gain, 'mlstm_w_out': mlstm_w_out,
            'attn_w_in': attn_w_in, 'attn_w_out': attn_w_out}


def reference(x, c, ada_w, ada_b, ln_g, ln_b, ffn_w_in, ffn_w_out, mlstm_w_in, mlstm_gate_bias,
              mlstm_conv_w, mlstm_head_gain, mlstm_w_out, attn_w_in, attn_w_out):
    B = x.shape[0]
    cond = jax.nn.silu(c)
    for layer in range(DEPTH):
        mod = (cond @ ada_w[layer] + ada_b[layer]).reshape(B, N_SUB, 3, 1, D_MODEL)

        def modulate(h, s):
            return h * (1.0 + mod[:, s, 1]) + mod[:, s, 0]

        def post(h, out, s, weight):
            return _layer_norm(ALPHA * h + weight * (1.0 + mod[:, s, 2]) * out, ln_g[layer, s], ln_b[layer, s])

        x = post(x, _swiglu(modulate(x, 0), ffn_w_in[layer, 0], ffn_w_out[layer, 0]), 0, 0.5)
        j = layer // N_MIXERS
        if layer % N_MIXERS == 0:
            y = _mlstm_mixer(modulate(x, 1), mlstm_w_in[j], mlstm_gate_bias[j], mlstm_conv_w[j],
                             mlstm_head_gain[j], mlstm_w_out[j])
        else:
            y = _dilated_mixer(modulate(x, 1), attn_w_in[j], attn_w_out[j])
        x = post(x, y, 1, 1.0)
        x = post(x, _swiglu(modulate(x, 2), ffn_w_in[layer, 1], ffn_w_out[layer, 1]), 2, 0.5)
    return x
```

```cpp
#include <hip/hip_runtime.h>
#include <hip/hip_cooperative_groups.h>
#include <cstdio>
#include <cstdint>
namespace cg = cooperative_groups;
namespace pg8 {
#define PG8_LAS __attribute__((address_space(3)))
typedef unsigned short bf16_t;
typedef short bf16x8 __attribute__((ext_vector_type(8)));
typedef float f32x4 __attribute__((ext_vector_type(4)));
typedef unsigned u32x4 __attribute__((ext_vector_type(4)));
constexpr int BM = 256, BK = 64, HALF = 128, HTB = HALF * BK * 2  , STAGE_BYTES = 8 * HTB, NXCD = 8, WGM = 8;

__host__ __device__ __forceinline__ int lds_byte(int r, int c) { const int st = (r >> 4) * 2 + (c >> 5), rr = r & 15, cc = c & 31, ob = rr * 64 + cc * 2; return st * 1024 + (ob ^ (((ob >> 9) & 1) << 5)); }
__host__ __device__ __forceinline__ void stage_rc(int b, int& R, int& C) { const int st = b / 1024, sb = b % 1024, swz = sb ^ (((sb >> 9) & 1) << 5); R = (st >> 1) * 16 + swz / 64; C = (st & 1) * 32 + (swz % 64) / 2; }
__host__ __device__ __forceinline__ int perm32(int rho) { const int n = rho >> 4, i = rho & 15; return 8 * (i >> 2) + 4 * n + (i & 3); }

struct Unit { int pm, pn; };
struct Gemm { const bf16_t* A; const bf16_t* Bt; int M, N, K; };

struct StaticOrder {
    int nM, nN, nwg, G, c;
    __host__ __device__ void init(int M, int N, int G_, int c_) { nM = M / BM; nN = N / BM; nwg = nM * nN; G = G_; c = c_; }
    __host__ __device__ bool next(int i, Unit& u) const {
        const long L = (long)i * G + c; if (L >= nwg) return false;
        int wgid = (int)L; { const int q = nwg / NXCD, r = nwg % NXCD, xcd = wgid % NXCD, off = wgid / NXCD; wgid = (xcd < r ? xcd * (q + 1) : r * (q + 1) + (xcd - r) * q) + off; }
        const int nig = WGM * nN, gid = wgid / nig, fm = gid * WGM, gsz = (nM - fm) < WGM ? (nM - fm) : WGM;
        u.pm = fm + ((wgid % nig) % gsz); u.pn = (wgid % nig) / gsz; return true;
    }
    __device__ __forceinline__ void a_ready(const Unit&) const {}
    __device__ __forceinline__ void done(const Unit&) const {}
};

__device__ __forceinline__ unsigned cvt_pk_bf16(float lo, float hi) { unsigned r; asm volatile("v_cvt_pk_bf16_f32 %0, %1, %2" : "=v"(r) : "v"(lo), "v"(hi)); return r; }
typedef float f32x2 __attribute__((ext_vector_type(2)));
template <class Epi, class Sched, bool ALIGN_EPI = false, bool SP2 = false>
__device__ __forceinline__ void gemm_phase(PG8_LAS unsigned char* lds, const Gemm g, const Sched& S, const Epi& E) {
    int tid_l = threadIdx.x; asm volatile("" : "+v"(tid_l)); const int tid = tid_l, wid = __builtin_amdgcn_readfirstlane(tid >> 6), lane = tid & 63, wr = wid >> 2, wc = wid & 3, fr = lane & 15, fq = lane >> 4;
    const int K = g.K, nt = K / BK;
    unsigned voffA[2], voffB[2];
#pragma unroll
    for (int i = 0; i < 2; ++i) { int R, C; stage_rc(tid * 16 + i * 8192, R, C); const int Rb = Epi::PERM ? ((R & ~31) + perm32(R & 31)) : R;
        voffA[i] = (unsigned)(R * K + C) * 2u; voffB[i] = (unsigned)(Rb * K + C) * 2u; }
    const size_t kstep = (size_t)(BK * 2);
    const size_t hstep = (size_t)HALF * K * 2;
    const size_t tstep = 2 * hstep;
    const unsigned ldsw = (unsigned)wid * 1024u;
    const int aoff = lds_byte(wr * 64 + fr, fq * 8), boff = lds_byte(wc * 32 + fr, fq * 8);
#define PG8_SA(b, h) (((b) * 2 + (h)) * HTB)
#define PG8_SB(b, h) ((4 + (b) * 2 + (h)) * HTB)
#define PG8_STAGE(bufoff, gbase, voff) do { _Pragma("unroll") for (int _i = 0; _i < 2; ++_i) \
        __builtin_amdgcn_global_load_lds((const unsigned*)((const char*)(gbase) + (voff)[_i]), (PG8_LAS unsigned*)(lds + (bufoff) + ldsw + _i * 8192), 16, 0, 0); } while (0)
#define PG8_LDA(dst, b, h) do { _Pragma("unroll") for (int m = 0; m < 4; ++m) _Pragma("unroll") for (int k = 0; k < 2; ++k) dst[m][k] = *(const PG8_LAS bf16x8*)(lds + PG8_SA(b, h) + aoff + m * 2048 + k * 1024); } while (0)
#define PG8_LDB(dst, b, h) do { _Pragma("unroll") for (int n = 0; n < 2; ++n) _Pragma("unroll") for (int k = 0; k < 2; ++k) dst[n][k] = *(const PG8_LAS bf16x8*)(lds + PG8_SB(b, h) + boff + n * 2048 + k * 1024); } while (0)
#define PG8_MMA(ai, bj, At, Bt) do { __builtin_amdgcn_s_setprio(1); _Pragma("unroll") for (int m = 0; m < 4; ++m) _Pragma("unroll") for (int n = 0; n < 2; ++n) _Pragma("unroll") for (int k = 0; k < 2; ++k) \
        acc[ai][bj][m][n] = __builtin_amdgcn_mfma_f32_16x16x32_bf16(Bt[n][k], At[m][k], acc[ai][bj][m][n], 0, 0, 0); __builtin_amdgcn_s_setprio(0); } while (0)
#define PG8_WAIT_V(n) asm volatile("s_waitcnt vmcnt(" #n ")" ::: "memory")
#define PG8_WAIT_L(n) asm volatile("s_waitcnt lgkmcnt(" #n ")" ::: "memory")
#define PG8_BAR __builtin_amdgcn_s_barrier()
#define PG8_SCHED __builtin_amdgcn_sched_barrier(0)
    Unit cur, nxt; int ui = 0;
    if (!S.next(0, cur)) return;
    f32x4 acc[2][2][4][2];
#pragma unroll
    for (int a = 0; a < 2; ++a)
#pragma unroll
        for (int b = 0; b < 2; ++b)
#pragma unroll
            for (int m = 0; m < 4; ++m)
#pragma unroll
                for (int n = 0; n < 2; ++n) acc[a][b][m][n] = (f32x4){0.f, 0.f, 0.f, 0.f};
    bf16x8 At[4][2], B0[2][2], B1[2][2];
    const char* cA = (const char*)g.A + (size_t)cur.pm * tstep; const char* cB = (const char*)g.Bt + (size_t)cur.pn * tstep;
    S.a_ready(cur);
    if constexpr (SP2) {
        PG8_STAGE(PG8_SB(0, 0), cB, voffB); PG8_STAGE(PG8_SB(0, 1), cB + hstep, voffB); PG8_STAGE(PG8_SA(0, 0), cA, voffA); PG8_STAGE(PG8_SA(0, 1), cA + hstep, voffA);
        if (wr == 1) PG8_BAR;
        PG8_WAIT_V(2); PG8_BAR;
        PG8_STAGE(PG8_SB(1, 0), cB + kstep, voffB); PG8_STAGE(PG8_SA(1, 0), cA + kstep, voffA); PG8_STAGE(PG8_SB(1, 1), cB + hstep + kstep, voffB);
        PG8_WAIT_V(6); PG8_BAR;
    } else {
        PG8_STAGE(PG8_SB(0, 0), cB, voffB); PG8_STAGE(PG8_SA(0, 0), cA, voffA); PG8_STAGE(PG8_SB(0, 1), cB + hstep, voffB); PG8_STAGE(PG8_SA(0, 1), cA + hstep, voffA);
        if (wr == 1) PG8_BAR;
        PG8_WAIT_V(4); PG8_BAR;
        PG8_STAGE(PG8_SB(1, 0), cB + kstep, voffB); PG8_STAGE(PG8_SA(1, 0), cA + kstep, voffA); PG8_STAGE(PG8_SB(1, 1), cB + hstep + kstep, voffB);
        PG8_WAIT_V(6); PG8_BAR;
    }
    for (;;) {
        const bool has_next = S.next(ui + 1, nxt);
        const char* nA = has_next ? (const char*)g.A + (size_t)nxt.pm * tstep : cA; const char* nB = has_next ? (const char*)g.Bt + (size_t)nxt.pn * tstep : cB;
        for (int t = 0; t < nt; t += 2) {
            const bool last = (t == nt - 2);
            const char* a1 = cA + (size_t)(t + 1) * kstep;
            const char* a2 = last ? nA : cA + (size_t)(t + 2) * kstep; const char* b2 = last ? nB : cB + (size_t)(t + 2) * kstep;
            const char* a3 = a2 + kstep; const char* b3 = b2 + kstep;
            if (last && has_next) S.a_ready(nxt);
            if constexpr (SP2) {
            PG8_LDB(B0, 0, 0); PG8_LDB(B1, 0, 1); PG8_SCHED; PG8_LDA(At, 0, 0); PG8_STAGE(PG8_SA(1, 1), a1 + hstep, voffA);
            PG8_WAIT_V(8); PG8_WAIT_L(0); PG8_BAR; PG8_MMA(0, 0, At, B0); PG8_MMA(0, 1, At, B1); PG8_BAR; PG8_SCHED;
            PG8_LDA(At, 0, 1); PG8_STAGE(PG8_SB(0, 0), b2, voffB); PG8_STAGE(PG8_SB(0, 1), b2 + hstep, voffB); PG8_STAGE(PG8_SA(0, 0), a2, voffA);
            PG8_WAIT_V(8); PG8_WAIT_L(0); PG8_BAR; PG8_MMA(1, 0, At, B0); PG8_MMA(1, 1, At, B1); PG8_BAR; PG8_SCHED;
            PG8_LDB(B0, 1, 0); PG8_LDB(B1, 1, 1); PG8_SCHED; PG8_LDA(At, 1, 0); PG8_STAGE(PG8_SA(0, 1), a2 + hstep, voffA);
            PG8_WAIT_V(8); PG8_WAIT_L(0); PG8_BAR; PG8_MMA(0, 0, At, B0); PG8_MMA(0, 1, At, B1); PG8_BAR; PG8_SCHED;
            PG8_LDA(At, 1, 1); PG8_STAGE(PG8_SB(1, 0), b3, voffB); PG8_STAGE(PG8_SB(1, 1), b3 + hstep, voffB); PG8_STAGE(PG8_SA(1, 0), a3, voffA);
            PG8_WAIT_V(8); PG8_WAIT_L(0); PG8_BAR; PG8_MMA(1, 0, At, B0); PG8_MMA(1, 1, At, B1); PG8_BAR; PG8_SCHED;
            } else {
            PG8_LDB(B0, 0, 0); PG8_SCHED; PG8_LDA(At, 0, 0); PG8_STAGE(PG8_SA(1, 1), a1 + hstep, voffA);
            PG8_WAIT_L(8); PG8_BAR; PG8_WAIT_L(0); PG8_MMA(0, 0, At, B0); PG8_BAR; PG8_SCHED;
            PG8_LDB(B1, 0, 1); PG8_STAGE(PG8_SB(0, 0), b2, voffB);
            PG8_BAR; PG8_WAIT_L(0); PG8_MMA(0, 1, At, B1); PG8_BAR;
            PG8_LDA(At, 0, 1); PG8_STAGE(PG8_SA(0, 0), a2, voffA);
            PG8_BAR; PG8_WAIT_L(0); PG8_MMA(1, 0, At, B0); PG8_BAR; PG8_SCHED;
            PG8_STAGE(PG8_SB(0, 1), b2 + hstep, voffB);
            PG8_WAIT_V(6); PG8_BAR; PG8_MMA(1, 1, At, B1); PG8_BAR;
            PG8_LDB(B0, 1, 0); PG8_SCHED; PG8_LDA(At, 1, 0); PG8_STAGE(PG8_SA(0, 1), a2 + hstep, voffA);
            PG8_WAIT_L(8); PG8_BAR; PG8_WAIT_L(0); PG8_MMA(0, 0, At, B0); PG8_BAR; PG8_SCHED;
            PG8_LDB(B1, 1, 1); PG8_STAGE(PG8_SB(1, 0), b3, voffB);
            PG8_BAR; PG8_WAIT_L(0); PG8_MMA(0, 1, At, B1); PG8_BAR;
            PG8_LDA(At, 1, 1); PG8_STAGE(PG8_SA(1, 0), a3, voffA);
            PG8_BAR; PG8_WAIT_L(0); PG8_MMA(1, 0, At, B0); PG8_BAR; PG8_SCHED;
            PG8_STAGE(PG8_SB(1, 1), b3 + hstep, voffB);
            PG8_WAIT_V(6); PG8_BAR; PG8_MMA(1, 1, At, B1); PG8_BAR;
            }
        }
        if constexpr (ALIGN_EPI) { if (wr == 0) PG8_BAR; }
        if constexpr (!Epi::AFTER_DRAIN) { E(acc, cur, wr, wc, fr, fq); S.done(cur); }
        if (!has_next) break;
#pragma unroll
        for (int a = 0; a < 2; ++a)
#pragma unroll
            for (int b = 0; b < 2; ++b)
#pragma unroll
                for (int m = 0; m < 4; ++m)
#pragma unroll
                    for (int n = 0; n < 2; ++n) acc[a][b][m][n] = (f32x4){0.f, 0.f, 0.f, 0.f};
        cur = nxt; cA = nA; cB = nB; ++ui;
        if constexpr (ALIGN_EPI) { if (wr == 1) PG8_BAR; }
    }
    PG8_WAIT_V(0);
    if constexpr (!ALIGN_EPI) { if (wr == 0) PG8_BAR; }
    PG8_BAR;
    if constexpr (Epi::AFTER_DRAIN) { E.fused(acc, cur, wr, wc, fr, fq, lds, wid, lane); S.done(cur); }
#undef PG8_SA
#undef PG8_SB
#undef PG8_STAGE
#undef PG8_LDA
#undef PG8_LDB
#undef PG8_MMA
#undef PG8_WAIT_V
#undef PG8_WAIT_L
#undef PG8_BAR
#undef PG8_SCHED
}
}

constexpr int NB = 16, SEQ = 4096, DM = 1024, DFF = 2816, T = NB * SEQ, NMOD = 9216;
constexpr float ALPHA_F = 1.41421356237309515f;
constexpr float LN_EPS_F = 1e-5f, RMS_EPS_F = 1e-6f;
constexpr size_t MiB = 1u << 20;
constexpr size_t OFF_MOD = 1 * MiB;
constexpr size_t OFF_STATS = 3 * MiB;
constexpr size_t OFF_LSE = 8 * MiB;
constexpr size_t OFF_W1 = 12 * MiB;
constexpr size_t OFF_W2 = 56 * MiB;
constexpr size_t OFF_WM = 78 * MiB;
constexpr size_t OFF_WMO = 85 * MiB;
constexpr size_t OFF_WA = 87 * MiB;
constexpr size_t OFF_WAO = 105 * MiB;
constexpr size_t OFF_H = 108 * MiB;
constexpr size_t OFF_Y = 236 * MiB;
constexpr size_t OFF_R = 364 * MiB;
constexpr size_t WS_END = 940 * MiB;
constexpr int LDS_BYTES = 135168;

typedef unsigned short bf16_t;
typedef short bf16x8 __attribute__((ext_vector_type(8)));
typedef float f32x4 __attribute__((ext_vector_type(4)));
typedef float f32x2 __attribute__((ext_vector_type(2)));
typedef unsigned u32x4 __attribute__((ext_vector_type(4)));
typedef unsigned u32x2 __attribute__((ext_vector_type(2)));
typedef short s16x4 __attribute__((ext_vector_type(4)));
#define LASQ __attribute__((address_space(3)))

__device__ __forceinline__ unsigned f2bf(float f) { unsigned u = __float_as_uint(f); return (u + 0x7fffu + ((u >> 16) & 1u)) >> 16; }
__device__ __forceinline__ unsigned pk2(float lo, float hi) { return pg8::cvt_pk_bf16(lo, hi); }
__device__ __forceinline__ float bf2f(unsigned short h) { return __uint_as_float(((unsigned)h) << 16); }
__device__ __forceinline__ float bflo(unsigned w) { return __uint_as_float(w << 16); }
__device__ __forceinline__ float bfhi(unsigned w) { return __uint_as_float(w & 0xffff0000u); }
__device__ __forceinline__ float wave_sum(float v) {
#pragma unroll
    for (int o = 1; o < 64; o <<= 1) v += __shfl_xor(v, o);
    return v;
}
__device__ __forceinline__ float wave_max(float v) {
#pragma unroll
    for (int o = 1; o < 64; o <<= 1) v = fmaxf(v, __shfl_xor(v, o));
    return v;
}
__device__ __forceinline__ float silu_f(float g) { return g * __builtin_amdgcn_rcpf(1.f + __expf(-g)); }
__device__ __forceinline__ float sigmoid_f(float g) { return __builtin_amdgcn_rcpf(1.f + __expf(-g)); }

struct Args { const float* in[15]; float* out; unsigned char* ws; int ph_lo, ph_hi; };

struct EpiSwiGLU {
    static constexpr bool PERM = true, AFTER_DRAIN = false;
    bf16_t* act;
    __device__ __forceinline__ void operator()(const f32x4 (&acc)[2][2][4][2], const pg8::Unit& u, int wr, int wc, int fr, int fq) const {
        const int row0 = u.pm * 256 + wr * 64 + fr, col0 = u.pn * 128 + wc * 32 + 8 * fq;
#pragma unroll
        for (int ai = 0; ai < 2; ++ai)
#pragma unroll
            for (int m = 0; m < 4; ++m) {
                bf16_t* p = act + (size_t)(row0 + ai * 128 + m * 16) * DFF + col0;
                const f32x4 g0 = acc[ai][0][m][0], g1 = acc[ai][0][m][1], u0 = acc[ai][1][m][0], u1 = acc[ai][1][m][1];
                u32x4 w;
                w.x = pk2(silu_f(g0[0]) * u0[0], silu_f(g0[1]) * u0[1]); w.y = pk2(silu_f(g0[2]) * u0[2], silu_f(g0[3]) * u0[3]);
                w.z = pk2(silu_f(g1[0]) * u1[0], silu_f(g1[1]) * u1[1]); w.w = pk2(silu_f(g1[2]) * u1[2], silu_f(g1[3]) * u1[3]);
                *(u32x4*)p = w;
            }
    }
};
struct EpiResidual {
    static constexpr bool PERM = false, AFTER_DRAIN = false;
    const float* vin; float* vout; const float* stats; const float* lng; const float* lnb; const float* gate; float wgt; int has_ln;
    __device__ __forceinline__ void operator()(const f32x4 (&acc)[2][2][4][2], const pg8::Unit& u, int wr, int wc, int fr, int fq) const {
        const int b = (u.pm * 256) >> 12;
        const int colb = u.pn * 256 + wc * 32 + 4 * fq;
        const float* gp = gate + (size_t)b * NMOD + colb;
#pragma unroll
        for (int bj = 0; bj < 2; ++bj)
#pragma unroll
            for (int n = 0; n < 2; ++n) {
                const int co = bj * 128 + n * 16;
                f32x4 gt = *(const f32x4*)(gp + co); gt = (gt + 1.0f) * wgt;
                f32x4 lg = (f32x4){ALPHA_F, ALPHA_F, ALPHA_F, ALPHA_F}, lb = (f32x4){0.f, 0.f, 0.f, 0.f};
                if (has_ln) { lg = *(const f32x4*)(lng + colb + co) * ALPHA_F; lb = *(const f32x4*)(lnb + colb + co) * ALPHA_F; }
#pragma unroll
                for (int ai = 0; ai < 2; ++ai)
#pragma unroll
                    for (int m = 0; m < 4; ++m) {
                        const int row = u.pm * 256 + ai * 128 + wr * 64 + m * 16 + fr;
                        const size_t off = (size_t)row * DM + colb + co;
                        f32x4 x = *(const f32x4*)(vin + off);
                        if (has_ln) { const f32x2 st = *(const f32x2*)(stats + 2 * (size_t)row); x = (x - st.x) * st.y; }
                        const f32x4 o = x * lg + lb + gt * acc[ai][bj][m][n];
                        *(f32x4*)(vout + off) = o;
                    }
            }
    }
};
struct EpiStoreBf16 {
    static constexpr bool PERM = true, AFTER_DRAIN = false;
    bf16_t* O; int ldc;
    __device__ __forceinline__ void operator()(const f32x4 (&acc)[2][2][4][2], const pg8::Unit& u, int wr, int wc, int fr, int fq) const {
        const int row0 = u.pm * 256 + wr * 64 + fr, col0 = u.pn * 256 + wc * 32 + 8 * fq;
#pragma unroll
        for (int ai = 0; ai < 2; ++ai)
#pragma unroll
            for (int m = 0; m < 4; ++m) {
                bf16_t* p = O + (size_t)(row0 + ai * 128 + m * 16) * ldc + col0;
#pragma unroll
                for (int bj = 0; bj < 2; ++bj) {
                    const f32x4 v0 = acc[ai][bj][m][0], v1 = acc[ai][bj][m][1];
                    u32x4 w; w.x = pk2(v0[0], v0[1]); w.y = pk2(v0[2], v0[3]); w.z = pk2(v1[0], v1[1]); w.w = pk2(v1[2], v1[3]);
                    *(u32x4*)(p + bj * 128) = w;
                }
            }
    }
};

__device__ __forceinline__ void transpose_item(const float* W, int K, int N, bf16_t* WT, int item, int nblk, bool perm_w1, bool qscale, float* scr, int lane) {
    const int kb = item / nblk, nb = item % nblk, k0 = 64 * kb, n0 = 32 * nb;
    const int ncol = n0 + (lane & 31);
#pragma unroll 8
    for (int i = 0; i < 32; ++i) { const int kk = 2 * i + (lane >> 5); scr[kk * 33 + (lane & 31)] = (ncol < N) ? W[(size_t)(k0 + kk) * N + ncol] : 0.f; }
    asm volatile("s_waitcnt lgkmcnt(0)" ::: "memory");
    int rbase = n0;
    if (perm_w1) rbase = (n0 < DFF) ? 256 * (n0 >> 7) + (n0 & 127) : 256 * ((n0 - DFF) >> 7) + 128 + ((n0 - DFF) & 127);
    const int c = lane & 7;
    const float sc = (qscale && (n0 % 3072) < 1024) ? 0.08838834764831845f * 1.4426950408889634f : 1.0f;
#pragma unroll
    for (int j = 0; j < 4; ++j) {
        const int n = (lane >> 3) + 8 * j; const float* s = scr + (8 * c) * 33 + n;
        u32x4 o; o.x = pk2(s[0 * 33] * sc, s[1 * 33] * sc); o.y = pk2(s[2 * 33] * sc, s[3 * 33] * sc); o.z = pk2(s[4 * 33] * sc, s[5 * 33] * sc); o.w = pk2(s[6 * 33] * sc, s[7 * 33] * sc);
        *(u32x4*)(WT + (size_t)(rbase + n) * K + k0 + 8 * c) = o;
    }
    asm volatile("s_waitcnt lgkmcnt(0)" ::: "memory");
}

__device__ __forceinline__ void p0_phase(const Args& a, unsigned char* lds, int tid, int lane, int wave) {
    float* sc = (float*)lds;
    float* red = (float*)(lds + 65536);
    const float* cin = a.in[1];
    for (int i = tid; i < 16 * 1024; i += 512) { const float v = cin[i]; sc[i] = silu_f(v); }
    __syncthreads();
    float* mod = (float*)(a.ws + OFF_MOD);
    for (int item = blockIdx.x; item < 288; item += gridDim.x) {
        const int l = item / 144, n0 = (item % 144) * 64;
        const float* W = a.in[2] + (size_t)l * 1024 * NMOD + n0 + lane;
        float acc[16];
#pragma unroll
        for (int b = 0; b < 16; ++b) acc[b] = 0.f;
        const int kb = wave * 128;
#pragma unroll 2
        for (int k = kb; k < kb + 128; k += 4) {
            const float w0 = W[(size_t)k * NMOD], w1 = W[(size_t)(k + 1) * NMOD], w2 = W[(size_t)(k + 2) * NMOD], w3 = W[(size_t)(k + 3) * NMOD];
#pragma unroll
            for (int b = 0; b < 16; ++b) { const f32x4 s = *(const f32x4*)(sc + b * 1024 + k); acc[b] += s[0] * w0 + s[1] * w1 + s[2] * w2 + s[3] * w3; }
        }
#pragma unroll
        for (int b = 0; b < 16; ++b) red[(wave * 16 + b) * 64 + lane] = acc[b];
        __syncthreads();
        for (int o = tid; o < 1024; o += 512) {
            const int b = o >> 6, n = o & 63; float s = 0.f;
#pragma unroll
            for (int w = 0; w < 8; ++w) s += red[(w * 16 + b) * 64 + n];
            mod[(size_t)(l * 16 + b) * NMOD + n0 + n] = s + a.in[3][l * NMOD + n0 + n];
        }
        __syncthreads();
    }
    float* scr = (float*)(lds + wave * 8448);
    const int gw = blockIdx.x * 8 + wave, NGW = gridDim.x * 8;
    constexpr int I_W1 = 16 * 176, I_W2 = 44 * 32, I_WM = 16 * 97, I_SQ = 16 * 32, I_WA = 16 * 288;
    constexpr int NITEMS = 4 * I_W1 + 4 * I_W2 + I_WM + I_SQ + I_WA + I_SQ;
    for (int it = gw; it < NITEMS; it += NGW) {
        int r = it;
        if (r < 4 * I_W1) { const int mi = r / I_W1; transpose_item(a.in[6] + (size_t)mi * 1024 * 5632, 1024, 5632, (bf16_t*)(a.ws + OFF_W1) + (size_t)mi * 5632 * 1024, r % I_W1, 176, true, false, scr, lane); continue; } r -= 4 * I_W1;
        if (r < 4 * I_W2) { const int mi = r / I_W2; transpose_item(a.in[7] + (size_t)mi * 2816 * 1024, 2816, 1024, (bf16_t*)(a.ws + OFF_W2) + (size_t)mi * 1024 * 2816, r % I_W2, 32, false, false, scr, lane); continue; } r -= 4 * I_W2;
        if (r < I_WM) { transpose_item(a.in[8], 1024, 3088, (bf16_t*)(a.ws + OFF_WM), r, 97, false, false, scr, lane); continue; } r -= I_WM;
        if (r < I_SQ) { transpose_item(a.in[12], 1024, 1024, (bf16_t*)(a.ws + OFF_WMO), r, 32, false, false, scr, lane); continue; } r -= I_SQ;
        if (r < I_WA) { transpose_item(a.in[13], 1024, 9216, (bf16_t*)(a.ws + OFF_WA), r, 288, false, true, scr, lane); continue; } r -= I_WA;
        transpose_item(a.in[14], 1024, 1024, (bf16_t*)(a.ws + OFF_WAO), r, 32, false, false, scr, lane);
    }
    for (int row = 3104 + gw; row < 3328; row += NGW) {
        u32x4* p = (u32x4*)((bf16_t*)(a.ws + OFF_WM) + (size_t)row * 1024);
        p[lane] = (u32x4){0u, 0u, 0u, 0u}; p[64 + lane] = (u32x4){0u, 0u, 0u, 0u};
    }
}

__device__ __forceinline__ void lnmod_phase(const float* vin, int has_ln, const float* lng, const float* lnb, const float* modl, int s,
                                            bf16_t* hout, float* stats, int lane, int wave) {
    const int gw = blockIdx.x * 8 + wave, NGW = gridDim.x * 8;
    for (int m = gw; m < T; m += NGW) {
        const int b = m >> 12;
        const f32x4* xr = (const f32x4*)(vin + (size_t)m * DM) + lane;
        f32x4 v[4];
#pragma unroll
        for (int j = 0; j < 4; ++j) v[j] = xr[64 * j];
        if (has_ln) {
            float sm = 0.f;
#pragma unroll
            for (int j = 0; j < 4; ++j) sm += (v[j][0] + v[j][1]) + (v[j][2] + v[j][3]);
            const float mean = wave_sum(sm) * (1.f / DM); float s2 = 0.f;
#pragma unroll
            for (int j = 0; j < 4; ++j) { v[j] = v[j] - mean; s2 += (v[j][0] * v[j][0] + v[j][1] * v[j][1]) + (v[j][2] * v[j][2] + v[j][3] * v[j][3]); }
            const float rstd = 1.f / sqrtf(wave_sum(s2) * (1.f / DM) + LN_EPS_F);
            if (lane == 0) *(f32x2*)(stats + 2 * (size_t)m) = (f32x2){mean, rstd};
#pragma unroll
            for (int j = 0; j < 4; ++j) { const f32x4 g = ((const f32x4*)lng)[lane + 64 * j], bb = ((const f32x4*)lnb)[lane + 64 * j]; v[j] = v[j] * rstd * g + bb; }
        }
        const f32x4* shp = (const f32x4*)(modl + (size_t)b * NMOD + (s * 3 + 0) * DM) + lane;
        const f32x4* scp = (const f32x4*)(modl + (size_t)b * NMOD + (s * 3 + 1) * DM) + lane;
        u32x2* o8 = (u32x2*)(hout + (size_t)m * DM) + lane;
#pragma unroll
        for (int j = 0; j < 4; ++j) {
            const f32x4 h = v[j] * (scp[64 * j] + 1.0f) + shp[64 * j];
            o8[64 * j] = (u32x2){pk2(h[0], h[1]), pk2(h[2], h[3])};
        }
    }
}
__device__ __forceinline__ void final_ln_phase(float* v_io, const float* lng, const float* lnb, int lane, int wave) {
    const int gw = blockIdx.x * 8 + wave, NGW = gridDim.x * 8;
    for (int m = gw; m < T; m += NGW) {
        f32x4* xr = (f32x4*)(v_io + (size_t)m * DM) + lane;
        f32x4 v[4]; float sm = 0.f;
#pragma unroll
        for (int j = 0; j < 4; ++j) { v[j] = xr[64 * j]; sm += (v[j][0] + v[j][1]) + (v[j][2] + v[j][3]); }
        const float mean = wave_sum(sm) * (1.f / DM); float s2 = 0.f;
#pragma unroll
        for (int j = 0; j < 4; ++j) { v[j] = v[j] - mean; s2 += (v[j][0] * v[j][0] + v[j][1] * v[j][1]) + (v[j][2] * v[j][2] + v[j][3] * v[j][3]); }
        const float rstd = 1.f / sqrtf(wave_sum(s2) * (1.f / DM) + LN_EPS_F);
#pragma unroll
        for (int j = 0; j < 4; ++j) { const f32x4 g = ((const f32x4*)lng)[lane + 64 * j], bb = ((const f32x4*)lnb)[lane + 64 * j]; xr[64 * j] = v[j] * rstd * g + bb; }
    }
}

__device__ __forceinline__ bf16x8 lds_b128(const unsigned char* p) { return *(const bf16x8*)p; }
__device__ __forceinline__ void mlstm_phase(const Args& a, unsigned char* lds, int tid, int lane, int wave) {
    const bf16_t* P = (const bf16_t*)(a.ws + OFF_R);
    constexpr int PLD = 3328;
    bf16_t* Y = (bf16_t*)(a.ws + OFF_Y);
    const float* gbias = a.in[9]; const float* convw = a.in[10]; const float* gain = a.in[11];
    unsigned char* Qs = lds;
    unsigned char* Ks = lds + 9216;
    unsigned char* KwT = lds + 18432;
    unsigned char* VsT = lds + 27648;
    unsigned char* Cb = lds + 46080;
    unsigned char* Pm = lds + 64512;
    float* fl = (float*)(lds + 81920);
    float* rowT = fl;
    float* colT = fl + 64;
    float* mL = fl + 128;
    float* nL = fl + 192;
    float* denL = fl + 256;
    float* ssqL = fl + 320;
    const int fr = lane & 15, fq = lane >> 4;
    const int it = wave >> 1, wh = wave & 1;
    for (int unit = blockIdx.x; unit < 128; unit += gridDim.x) {
        const int b = unit >> 3, h = unit & 7;
        f32x4 Cacc[4];
#pragma unroll
        for (int kt = 0; kt < 4; ++kt) Cacc[kt] = (f32x4){0.f, 0.f, 0.f, 0.f};
        float nreg = 0.f, m_prev = 0.f;
        __syncthreads();
        for (int i = tid; i < 128 * 72 / 2; i += 512) ((unsigned*)Cb)[i] = 0u;
        if (tid < 64) nL[tid] = 0.f;
        const int isk = wave & 1, kk = lane, tq = wave >> 1;
        const int gcol = isk * 512 + h * 64 + kk;
        const float cw0 = convw[gcol], cw1 = convw[1024 + gcol], cw2 = convw[2048 + gcol], cw3 = convw[3072 + gcol];
        const float gb_i = gbias[h], gb_f = gbias[8 + h];
        for (int c = 0; c < 64; ++c) {
            const int t0 = c * 64; const size_t rowbase = (size_t)b * SEQ + t0;
            const float ig = bf2f(P[(rowbase + lane) * PLD + 3072 + h]) + gb_i;
            const float fp = bf2f(P[(rowbase + lane) * PLD + 3080 + h]) + gb_f;
            const float lf = fminf(fp, 0.f) - log1pf(__expf(-fabsf(fp)));
            float bc = lf;
#pragma unroll
            for (int o = 1; o < 64; o <<= 1) { const float t = __shfl_up(bc, o); if (lane >= o) bc += t; }
            const float blast = __shfl(bc, 63);
            const float av = blast - bc + ig;
            const float mloc = wave_max(av);
            const float mnew = fmaxf(blast + m_prev, mloc);
            const float sp = __expf(blast + m_prev - mnew);
            const float wa = __expf(av - mnew);
            float pmx = ig - bc;
#pragma unroll
            for (int o = 1; o < 64; o <<= 1) { const float t = __shfl_up(pmx, o); if (lane >= o) pmx = fmaxf(pmx, t); }
            const float mi = fmaxf(bc + m_prev, bc + pmx);
            const float iw = __expf(bc + m_prev - mi);
            if (wave == 0) { rowT[lane] = bc - mi; colT[lane] = ig - bc; mL[lane] = mi; }
            {
                float x[19];
                const bf16_t* pu = P + (size_t)b * SEQ * PLD;
#pragma unroll
                for (int e = 0; e < 19; ++e) {
                    const int tt = t0 + 16 * tq - 3 + e;
                    const unsigned off = (unsigned)(tt < 0 ? 0 : tt) * (unsigned)PLD + (unsigned)gcol;
                    const float xv = bf2f(pu[off]);
                    x[e] = (tt >= 0) ? xv : 0.f;
                }
#pragma unroll
                for (int e = 0; e < 16; ++e) {
                    const int j = 16 * tq + e;
                    float y = cw0 * x[e] + cw1 * x[e + 1] + cw2 * x[e + 2] + cw3 * x[e + 3];
                    y = silu_f(y);
                    if (!isk) {
                        const float qs = y * 0.125f; const float iwj = __shfl(iw, j);
                        *(bf16_t*)(Qs + (j * 72 + kk) * 2) = (bf16_t)f2bf(qs);
                        *(bf16_t*)(Pm + (j * 136 + 64 + kk) * 2) = (bf16_t)f2bf(iwj * qs);
                    } else {
                        const float waj = __shfl(wa, j);
                        *(bf16_t*)(Ks + (j * 72 + kk) * 2) = (bf16_t)f2bf(y);
                        *(bf16_t*)(KwT + (kk * 72 + j) * 2) = (bf16_t)f2bf(waj * y);
                    }
                }
                const u32x4* vp = (const u32x4*)(P + (rowbase + lane) * PLD + 1024 + h * 128 + 16 * wave);
                const u32x4 va = vp[0], vb = vp[1];
                const unsigned vw[8] = {va.x, va.y, va.z, va.w, vb.x, vb.y, vb.z, vb.w};
#pragma unroll
                for (int e = 0; e < 8; ++e) {
                    *(bf16_t*)(VsT + ((16 * wave + 2 * e) * 72 + lane) * 2) = (bf16_t)(vw[e] & 0xffffu);
                    *(bf16_t*)(VsT + ((16 * wave + 2 * e + 1) * 72 + lane) * 2) = (bf16_t)(vw[e] >> 16);
                }
            }
            __syncthreads();
#pragma unroll
            for (int jj2 = 0; jj2 < 2; ++jj2) {
                const int jt = 2 * wh + jj2;
                f32x4 s = (f32x4){0.f, 0.f, 0.f, 0.f};
#pragma unroll
                for (int ks = 0; ks < 2; ++ks) {
                    const bf16x8 kf = lds_b128(Ks + ((16 * jt + fr) * 72 + 32 * ks + 8 * fq) * 2);
                    const bf16x8 qf = lds_b128(Qs + ((16 * it + fr) * 72 + 32 * ks + 8 * fq) * 2);
                    s = __builtin_amdgcn_mfma_f32_16x16x32_bf16(kf, qf, s, 0, 0, 0);
                }
                const int i = 16 * it + fr; const float rt = rowT[i];
                float p[4];
#pragma unroll
                for (int e = 0; e < 4; ++e) { const int j = 16 * jt + 4 * fq + e; p[e] = (j <= i) ? s[e] * __expf(rt + colT[j]) : 0.f; }
                *(u32x2*)(Pm + (i * 136 + 16 * jt + 4 * fq) * 2) = (u32x2){pk2(p[0], p[1]), pk2(p[2], p[3])};
            }
            __syncthreads();
            f32x4 nacc[4];
#pragma unroll
            for (int v4 = 0; v4 < 4; ++v4) {
                const int vt = 4 * wh + v4; f32x4 acc = (f32x4){0.f, 0.f, 0.f, 0.f};
#pragma unroll
                for (int ks = 0; ks < 4; ++ks) {
                    const bf16x8 af = (ks < 2) ? lds_b128(VsT + ((16 * vt + fr) * 72 + 32 * ks + 8 * fq) * 2)
                                               : lds_b128(Cb + ((16 * vt + fr) * 72 + 32 * (ks - 2) + 8 * fq) * 2);
                    const bf16x8 bfr = lds_b128(Pm + ((16 * it + fr) * 136 + 32 * ks + 8 * fq) * 2);
                    acc = __builtin_amdgcn_mfma_f32_16x16x32_bf16(af, bfr, acc, 0, 0, 0);
                }
                nacc[v4] = acc;
            }
            if (wave == 0) {
                float d = 0.f;
#pragma unroll 2
                for (int q8 = 0; q8 < 16; ++q8) {
                    const u32x4 w = *(const u32x4*)(Pm + (lane * 136 + 8 * q8) * 2);
                    if (q8 < 8) d += (bflo(w.x) + bfhi(w.x)) + (bflo(w.y) + bfhi(w.y)) + (bflo(w.z) + bfhi(w.z)) + (bflo(w.w) + bfhi(w.w));
                    else { const float* np = nL + 8 * (q8 - 8);
                        d += bflo(w.x) * np[0] + bfhi(w.x) * np[1] + bflo(w.y) * np[2] + bfhi(w.y) * np[3] + bflo(w.z) * np[4] + bfhi(w.z) * np[5] + bflo(w.w) * np[6] + bfhi(w.w) * np[7]; }
                }
                denL[lane] = d;
                float ns = 0.f;
#pragma unroll 2
                for (int q8 = 0; q8 < 8; ++q8) {
                    const u32x4 w = *(const u32x4*)(KwT + (lane * 72 + 8 * q8) * 2);
                    ns += (bflo(w.x) + bfhi(w.x)) + (bflo(w.y) + bfhi(w.y)) + (bflo(w.z) + bfhi(w.z)) + (bflo(w.w) + bfhi(w.w));
                }
                nreg = sp * nreg + ns;
            }
#pragma unroll
            for (int kt = 0; kt < 4; ++kt) {
                f32x4 cc = Cacc[kt] * sp;
#pragma unroll
                for (int ks = 0; ks < 2; ++ks) {
                    const bf16x8 af = lds_b128(VsT + ((16 * wave + fr) * 72 + 32 * ks + 8 * fq) * 2);
                    const bf16x8 bfr = lds_b128(KwT + ((16 * kt + fr) * 72 + 32 * ks + 8 * fq) * 2);
                    cc = __builtin_amdgcn_mfma_f32_16x16x32_bf16(af, bfr, cc, 0, 0, 0);
                }
                Cacc[kt] = cc;
            }
            __syncthreads();
#pragma unroll
            for (int kt = 0; kt < 4; ++kt)
#pragma unroll
                for (int e = 0; e < 4; ++e) *(bf16_t*)(Cb + ((16 * wave + 4 * fq + e) * 72 + 16 * kt + fr) * 2) = (bf16_t)f2bf(Cacc[kt][e]);
            if (wave == 0) nL[lane] = nreg;
            const int irow = 16 * it + fr;
            const float dn = fmaxf(fabsf(denL[irow]), __expf(-mL[irow]));
            const float rdn = 1.0f / dn;
            float sq = 0.f;
#pragma unroll
            for (int v4 = 0; v4 < 4; ++v4) { nacc[v4] = nacc[v4] * rdn; sq += (nacc[v4][0] * nacc[v4][0] + nacc[v4][1] * nacc[v4][1]) + (nacc[v4][2] * nacc[v4][2] + nacc[v4][3] * nacc[v4][3]); }
            sq += __shfl_xor(sq, 16); sq += __shfl_xor(sq, 32);
            if (fq == 0) ssqL[irow * 2 + wh] = sq;
            __syncthreads();
            const float rn = 1.0f / sqrtf((ssqL[irow * 2] + ssqL[irow * 2 + 1]) * (1.f / 128.f) + RMS_EPS_F);
#pragma unroll
            for (int v4 = 0; v4 < 4; ++v4) {
                const int v = 16 * (4 * wh + v4) + 4 * fq;
                const u32x2 ow = *(const u32x2*)(P + (rowbase + irow) * PLD + 2048 + h * 128 + v);
                const f32x4 gn = *(const f32x4*)(gain + h * 128 + v);
                const float y0 = sigmoid_f(bflo(ow.x)) * nacc[v4][0] * rn * gn[0], y1 = sigmoid_f(bfhi(ow.x)) * nacc[v4][1] * rn * gn[1];
                const float y2 = sigmoid_f(bflo(ow.y)) * nacc[v4][2] * rn * gn[2], y3 = sigmoid_f(bfhi(ow.y)) * nacc[v4][3] * rn * gn[3];
                *(u32x2*)(Y + (rowbase + irow) * 1024 + h * 128 + v) = (u32x2){pk2(y0, y1), pk2(y2, y3)};
            }
            m_prev = mnew;
        }
    }
}

struct AttnUnit { int bl, g, h, dil, r, u0, hasprev; };
__device__ __forceinline__ AttnUnit attn_decode(int ui) {
    AttnUnit U; const int tile = ui & 31; U.h = (ui >> 5) & 7; const int rest = ui >> 8; U.g = rest % 3; U.bl = rest / 3;
    U.dil = (U.g == 0) ? 1 : (U.g == 1 ? 4 : 16);
    const int lpr = SEQ / U.dil, pos0 = 128 * tile; U.r = pos0 / lpr; U.u0 = pos0 % lpr; U.hasprev = (U.u0 > 0) ? 1 : 0;
    return U;
}
__device__ __forceinline__ s16x4 lds_tr(const unsigned char* p) {
    typedef short v4i16_t __attribute__((ext_vector_type(4)));
    return __builtin_bit_cast(s16x4, __builtin_amdgcn_ds_read_tr16_b64_v4i16((LASQ v4i16_t*)(p)));
}
__device__ __forceinline__ void attn_phase(const Args& a, unsigned char* lds, int tid, int lane, int wave) {
    bf16_t* QKV = (bf16_t*)(a.ws + OFF_R);
    float* lse = (float*)(a.ws + OFF_LSE);
    unsigned char* Kl = lds;
    unsigned char* Vl = lds + 34816;
    const int fr = lane & 15, fq = lane >> 4;
    const int NU = 8 * 3 * 8 * 32, GS = gridDim.x;
    int ui = blockIdx.x;
    if (ui >= NU) return;
    AttnUnit U = attn_decode(ui);
    int st = U.hasprev ? 0 : 1;
    u32x4 kreg[4], vreg[4];
    bf16x8 qnext[4], qf[4];
    auto load_stage = [&](const AttnUnit& X, int stg) {
        const int ub = X.u0 + (stg ? 0 : -128);
        const size_t cb = (size_t)X.g * 3072 + X.h * 128;
#pragma unroll
        for (int q = 0; q < 4; ++q) {
            const int cid = tid + 512 * q, key = cid >> 4, part = cid & 15;
            const size_t row = (size_t)X.bl * SEQ + (size_t)(ub + key) * X.dil + X.r;
            const bf16_t* p = QKV + row * 9216 + cb + part * 8;
            kreg[q] = *(const u32x4*)(p + 1024); vreg[q] = *(const u32x4*)(p + 2048);
        }
    };
    auto load_q = [&](const AttnUnit& X) {
        const size_t row = (size_t)X.bl * SEQ + (size_t)(X.u0 + 16 * wave + fr) * X.dil + X.r;
        const bf16_t* p = QKV + row * 9216 + (size_t)X.g * 3072 + X.h * 128 + 8 * fq;
#pragma unroll
        for (int ks = 0; ks < 4; ++ks) qnext[ks] = *(const bf16x8*)(p + 32 * ks);
    };
    load_stage(U, st); load_q(U);
    float mrow = -1e30f, lrow = 0.f;
    f32x4 oacc[8];
    bool first = true;
    for (;;) {
        AttnUnit Un = U; int stn; bool validn = true, firstn = false;
        if (st == 0) stn = 1;
        else { const int uin = ui + GS; if (uin < NU) { Un = attn_decode(uin); stn = Un.hasprev ? 0 : 1; firstn = true; } else { validn = false; stn = 1; } }
        __syncthreads();
#pragma unroll
        for (int q = 0; q < 4; ++q) {
            const int cid = tid + 512 * q, key = cid >> 4, part = cid & 15;
            *(u32x4*)(Kl + key * 272 + part * 16) = kreg[q];
            *(u32x4*)(Vl + key * 288 + part * 16) = vreg[q];
        }
        if (first) {
#pragma unroll
            for (int ks = 0; ks < 4; ++ks) qf[ks] = qnext[ks];
            mrow = -1e30f; lrow = 0.f;
#pragma unroll
            for (int vt = 0; vt < 8; ++vt) oacc[vt] = (f32x4){0.f, 0.f, 0.f, 0.f};
        }
        __syncthreads();
        if (validn) { load_stage(Un, stn); if (firstn) load_q(Un); }
        const int plo = (st == 0) ? (wave >> 1) : 0, phi = (st == 0) ? 3 : (wave >> 1);
        const int iq = 16 * wave + fr;
        for (int p = plo; p <= phi; ++p) {
            f32x4 s[2];
#pragma unroll
            for (int k2 = 0; k2 < 2; ++k2) {
                f32x4 acc = (f32x4){0.f, 0.f, 0.f, 0.f};
#pragma unroll
                for (int ks = 0; ks < 4; ++ks) {
                    const bf16x8 kf = *(const bf16x8*)(Kl + (32 * p + 16 * k2 + fr) * 272 + (32 * ks + 8 * fq) * 2);
                    acc = __builtin_amdgcn_mfma_f32_16x16x32_bf16(kf, qf[ks], acc, 0, 0, 0);
                }
                s[k2] = acc;
            }
            float mx = -1e30f;
#pragma unroll
            for (int k2 = 0; k2 < 2; ++k2)
#pragma unroll
                for (int e = 0; e < 4; ++e) {
                    const int j = 32 * p + 16 * k2 + 4 * fq + e;
                    const bool ok = (st == 0) ? (j >= iq) : (j <= iq);
                    s[k2][e] = ok ? s[k2][e] : -1e30f;
                    mx = fmaxf(mx, s[k2][e]);
                }
            mx = fmaxf(mx, __shfl_xor(mx, 16)); mx = fmaxf(mx, __shfl_xor(mx, 32));
            const float mnew = fmaxf(mrow, mx);
            const float alpha = __builtin_amdgcn_exp2f(mrow - mnew);
            float ps = 0.f; float pe[8];
#pragma unroll
            for (int k2 = 0; k2 < 2; ++k2)
#pragma unroll
                for (int e = 0; e < 4; ++e) { const float pv = __builtin_amdgcn_exp2f(s[k2][e] - mnew); pe[4 * k2 + e] = pv; ps += pv; }
            lrow = lrow * alpha + ps; mrow = mnew;
            const u32x4 pw = (u32x4){pk2(pe[0], pe[1]), pk2(pe[2], pe[3]), pk2(pe[4], pe[5]), pk2(pe[6], pe[7])};
            const bf16x8 pfrag = __builtin_bit_cast(bf16x8, pw);
            const unsigned char* vb0 = Vl + (32 * p + 4 * fq + (fr >> 2)) * 288 + (4 * (fr & 3)) * 2;
#pragma unroll
            for (int vt = 0; vt < 8; ++vt) {
                const s16x4 lo = lds_tr(vb0 + 32 * vt);
                const s16x4 hi = lds_tr(vb0 + 16 * 288 + 32 * vt);
                const bf16x8 vf = (bf16x8){lo[0], lo[1], lo[2], lo[3], hi[0], hi[1], hi[2], hi[3]};
                oacc[vt] = __builtin_amdgcn_mfma_f32_16x16x32_bf16(vf, pfrag, oacc[vt] * alpha, 0, 0, 0);
            }
        }
        if (st == 1) {
            float lt = lrow; lt += __shfl_xor(lt, 16); lt += __shfl_xor(lt, 32);
            const float inv = 1.0f / lt;
            const size_t row = (size_t)U.bl * SEQ + (size_t)(U.u0 + iq) * U.dil + U.r;
            bf16_t* op = QKV + row * 9216 + (size_t)U.g * 3072 + U.h * 128 + 4 * fq;
#pragma unroll
            for (int vt = 0; vt < 8; ++vt) { const f32x4 o = oacc[vt] * inv; *(u32x2*)(op + 16 * vt) = (u32x2){pk2(o[0], o[1]), pk2(o[2], o[3])}; }
            if (fq == 0) lse[((size_t)U.g * 32768 + row) * 8 + U.h] = (mrow + __builtin_amdgcn_logf(lt)) * 0.6931471805599453f;
        }
        if (!validn) break;
        if (st == 1) ui += GS;
        first = firstn; U = Un; st = stn;
    }
}
__device__ __forceinline__ void attn_merge_phase(const Args& a, int half, int lane, int wave) {
    const bf16_t* QKV = (const bf16_t*)(a.ws + OFF_R);
    const float* lse = (const float*)(a.ws + OFF_LSE);
    bf16_t* Y = (bf16_t*)(a.ws + OFF_Y) + (size_t)half * 32768 * 1024;
    const int gw = blockIdx.x * 8 + wave, NGW = gridDim.x * 8;
    const int hh = lane >> 3, d0 = (lane & 7) * 16;
    for (int rl = gw; rl < 32768; rl += NGW) {
        float ls[3], mx = -1e30f;
#pragma unroll
        for (int g = 0; g < 3; ++g) { ls[g] = lse[((size_t)g * 32768 + rl) * 8 + hh]; mx = fmaxf(mx, ls[g]); }
        float w[3], ws = 0.f;
#pragma unroll
        for (int g = 0; g < 3; ++g) { w[g] = __expf(ls[g] - mx); ws += w[g]; }
        const float iws = 1.0f / ws;
        float o[16];
#pragma unroll
        for (int e = 0; e < 16; ++e) o[e] = 0.f;
#pragma unroll
        for (int g = 0; g < 3; ++g) {
            const u32x4* p = (const u32x4*)(QKV + (size_t)rl * 9216 + g * 3072 + hh * 128 + d0);
            const u32x4 x0 = p[0], x1 = p[1]; const float wg = w[g] * iws;
            const unsigned xw[8] = {x0.x, x0.y, x0.z, x0.w, x1.x, x1.y, x1.z, x1.w};
#pragma unroll
            for (int e = 0; e < 8; ++e) { o[2 * e] += wg * bflo(xw[e]); o[2 * e + 1] += wg * bfhi(xw[e]); }
        }
        u32x4* yp = (u32x4*)(Y + (size_t)rl * 1024 + hh * 128 + d0);
        yp[0] = (u32x4){pk2(o[0], o[1]), pk2(o[2], o[3]), pk2(o[4], o[5]), pk2(o[6], o[7])};
        yp[1] = (u32x4){pk2(o[8], o[9]), pk2(o[10], o[11]), pk2(o[12], o[13]), pk2(o[14], o[15])};
    }
}

template <class Epi> __device__ __forceinline__ void run_gemm(unsigned char* lds, const bf16_t* A, const bf16_t* Bt, int M, int N, int K, const Epi& E) {
    pg8::Gemm g{A, Bt, M, N, K}; pg8::StaticOrder S; S.init(M, N, (int)gridDim.x, (int)blockIdx.x);
    pg8::gemm_phase<Epi, pg8::StaticOrder, true, true>((PG8_LAS unsigned char*)lds, g, S, E);
}
#ifndef EN
#define EN 0xFFFF
#endif
enum { PT_P0 = 0, PT_LNMOD, PT_G1, PT_RES, PT_MPROJ, PT_MCELL, PT_QKV, PT_ATT, PT_MERGE, PT_FINAL };
constexpr int N_PHASES = 26;
__device__ __forceinline__ void phase_desc(int ph, int& type, int& l, int& s, int& x) {
    type = PT_P0; l = 0; s = 0; x = 0;
    switch (ph) {
        case 0: type = PT_P0; break;
        case 1: type = PT_LNMOD; l = 0; s = 0; break;
        case 2: type = PT_G1; l = 0; x = 0; break;
        case 3: type = PT_RES; l = 0; s = 0; break;
        case 4: type = PT_LNMOD; l = 0; s = 1; break;
        case 5: type = PT_MPROJ; break;
        case 6: type = PT_MCELL; break;
        case 7: type = PT_RES; l = 0; s = 1; break;
        case 8: type = PT_LNMOD; l = 0; s = 2; break;
        case 9: type = PT_G1; l = 0; x = 1; break;
        case 10: type = PT_RES; l = 0; s = 2; break;
        case 11: type = PT_LNMOD; l = 1; s = 0; break;
        case 12: type = PT_G1; l = 1; x = 0; break;
        case 13: type = PT_RES; l = 1; s = 0; break;
        case 14: type = PT_LNMOD; l = 1; s = 1; break;
        case 15: type = PT_QKV; x = 0; break;
        case 16: type = PT_ATT; x = 0; break;
        case 17: type = PT_MERGE; x = 0; break;
        case 18: type = PT_QKV; x = 1; break;
        case 19: type = PT_ATT; x = 1; break;
        case 20: type = PT_MERGE; x = 1; break;
        case 21: type = PT_RES; l = 1; s = 1; break;
        case 22: type = PT_LNMOD; l = 1; s = 2; break;
        case 23: type = PT_G1; l = 1; x = 1; break;
        case 24: type = PT_RES; l = 1; s = 2; break;
        default: type = PT_FINAL; break;
    }
}

__global__ void __launch_bounds__(512, 2) fwd_kernel(Args a_unused) {
#if defined(__HIP_DEVICE_COMPILE__)
    extern __shared__ __attribute__((aligned(16))) unsigned char lds[];
    cg::grid_group grid = cg::this_grid();
    typedef __attribute__((address_space(4))) const Args* KArgsPtr;
    KArgsPtr ap = (KArgsPtr)__builtin_amdgcn_kernarg_segment_ptr();
    const int ph_lo = ap->ph_lo;
    for (int ph = ph_lo; ; ++ph) {
        asm volatile("" : "+s"(ap));
        Args a;
#pragma unroll
        for (int i = 0; i < 15; ++i) a.in[i] = ap->in[i];
        a.out = ap->out; a.ws = ap->ws; a.ph_lo = ap->ph_lo; a.ph_hi = ap->ph_hi;
        int tid_l = threadIdx.x; asm volatile("" : "+v"(tid_l));
        const int tid = tid_l, lane = tid & 63, wave = __builtin_amdgcn_readfirstlane(tid >> 6);
        unsigned char* ws = a.ws;
        float* mod = (float*)(ws + OFF_MOD); float* stats = (float*)(ws + OFF_STATS);
        const float* x_in = a.in[0]; const float* lng = a.in[4]; const float* lnb = a.in[5];
        float* v = a.out;
        bf16_t* H = (bf16_t*)(ws + OFF_H); bf16_t* Yb = (bf16_t*)(ws + OFF_Y); bf16_t* R = (bf16_t*)(ws + OFF_R);
        if (ph >= a.ph_hi) break;
        int type, l, s, x; phase_desc(ph, type, l, s, x);
        const int q = 3 * l + s;
        const int has_ln = (q > 0) ? 1 : 0;
        const float* pg = lng + (size_t)(q > 0 ? q - 1 : 0) * DM; const float* pb = lnb + (size_t)(q > 0 ? q - 1 : 0) * DM;
        const float* vin = (q > 0) ? (const float*)v : x_in;
        const float* modl = mod + (size_t)l * 16 * NMOD;
        if (type == PT_P0 && (EN >> PT_P0 & 1)) {
            p0_phase(a, lds, tid, lane, wave);
        } else if (type == PT_LNMOD && (EN >> PT_LNMOD & 1)) {
            lnmod_phase(vin, has_ln, pg, pb, modl, s, H, stats, lane, wave);
        } else if (type == PT_G1 && (EN >> PT_G1 & 1)) {
            EpiSwiGLU E{R};
            run_gemm(lds, H, (const bf16_t*)(ws + OFF_W1) + (size_t)(l * 2 + x) * 5632 * 1024, T, 5632, 1024, E);
        } else if (type == PT_RES && (EN >> PT_RES & 1)) {
            const bf16_t* A; const bf16_t* Bt; int K; float wgt;
            if (s == 1) { A = Yb; Bt = (const bf16_t*)(ws + (l == 0 ? OFF_WMO : OFF_WAO)); K = 1024; wgt = 1.0f; }
            else { A = R; Bt = (const bf16_t*)(ws + OFF_W2) + (size_t)(l * 2 + (s >> 1)) * 1024 * 2816; K = 2816; wgt = 0.5f; }
            EpiResidual E{vin, v, stats, pg, pb, modl + (s * 3 + 2) * DM, wgt, has_ln};
            run_gemm(lds, A, Bt, T, 1024, K, E);
        } else if (type == PT_MPROJ && (EN >> PT_MPROJ & 1)) {
            EpiStoreBf16 E{R, 3328};
            run_gemm(lds, H, (const bf16_t*)(ws + OFF_WM), T, 3328, 1024, E);
        } else if (type == PT_MCELL && (EN >> PT_MCELL & 1)) {
            mlstm_phase(a, lds, tid, lane, wave);
        } else if (type == PT_QKV && (EN >> PT_QKV & 1)) {
            EpiStoreBf16 E{R, 9216};
            run_gemm(lds, H + (size_t)x * 32768 * 1024, (const bf16_t*)(ws + OFF_WA), 32768, 9216, 1024, E);
        } else if (type == PT_ATT && (EN >> PT_ATT & 1)) {
            attn_phase(a, lds, tid, lane, wave);
        } else if (type == PT_MERGE && (EN >> PT_MERGE & 1)) {
            attn_merge_phase(a, x, lane, wave);
        } else {
            final_ln_phase(v, lng + 5 * DM, lnb + 5 * DM, lane, wave);
        }
        asm volatile("" : "+s"(ap));
        if (ph + 1 < ap->ph_hi) grid.sync();
    }
#endif
}

#ifndef MK_SPLIT
#define MK_SPLIT 0
#endif
extern "C" void kernel_launch(void* const* d_in, const int* in_sizes, int n_in, void* d_out, int out_size, void* d_ws, size_t ws_size, hipStream_t stream) {
    static int grid = 0;
    if (grid == 0) {
        if (n_in != 15 || out_size != T * DM || ws_size < WS_END) { fprintf(stderr, "kernel_launch: unexpected shapes (n_in %d out %d ws %zu)\n", n_in, out_size, ws_size); grid = -1; return; }
        int dev = 0, cus = 0, per_cu = 0;
        (void)hipGetDevice(&dev);
        (void)hipDeviceGetAttribute(&cus, hipDeviceAttributeMultiprocessorCount, dev);
        if (hipFuncSetAttribute((const void*)fwd_kernel, hipFuncAttributeMaxDynamicSharedMemorySize, LDS_BYTES) != hipSuccess) { fprintf(stderr, "kernel_launch: hipFuncSetAttribute failed\n"); grid = -1; return; }
        if (hipOccupancyMaxActiveBlocksPerMultiprocessor(&per_cu, (const void*)fwd_kernel, 512, LDS_BYTES) != hipSuccess || per_cu < 1) { fprintf(stderr, "kernel_launch: occupancy query says %d\n", per_cu); per_cu = 1; }
        (void)hipGetLastError();
        if (cus <= 0) cus = 256;
        grid = cus * 1;
    }
    if (grid < 0) return;
    Args a{};
    for (int i = 0; i < 15; ++i) a.in[i] = (const float*)d_in[i];
    a.out = (float*)d_out; a.ws = (unsigned char*)d_ws;
#if MK_SPLIT
    for (int ph = 0; ph < N_PHASES; ++ph) {
        a.ph_lo = ph; a.ph_hi = ph + 1;
        void* args[] = {&a};
        hipError_t e = hipLaunchCooperativeKernel((const void*)fwd_kernel, dim3(grid), dim3(512), args, LDS_BYTES, stream);
        if (e != hipSuccess) { fprintf(stderr, "kernel_launch: cooperative launch failed: %s\n", hipGetErrorString(e)); break; }
    }
#else
    a.ph_lo = 0; a.ph_hi = N_PHASES;
    void* args[] = {&a};
    hipError_t e = hipLaunchCooperativeKernel((const void*)fwd_kernel, dim3(grid), dim3(512), args, LDS_BYTES, stream);
    if (e != hipSuccess) fprintf(stderr, "kernel_launch: cooperative launch failed: %s (grid %d)\n", hipGetErrorString(e), grid);
#endif
}
```

```cpp
#include <hip/hip_runtime.h>
#include <hip/hip_cooperative_groups.h>
#include <cstdio>
#include <cstdint>
namespace cg = cooperative_groups;
namespace pg8 {
#define PG8_LAS __attribute__((address_space(3)))
typedef unsigned short bf16_t;
typedef short bf16x8 __attribute__((ext_vector_type(8)));
typedef float f32x4 __attribute__((ext_vector_type(4)));
typedef unsigned u32x4 __attribute__((ext_vector_type(4)));
constexpr int BM = 256, BK = 64, HALF = 128, HTB = HALF * BK * 2  , STAGE_BYTES = 8 * HTB, NXCD = 8, WGM = 8;

__host__ __device__ __forceinline__ int lds_byte(int r, int c) { const int st = (r >> 4) * 2 + (c >> 5), rr = r & 15, cc = c & 31, ob = rr * 64 + cc * 2; return st * 1024 + (ob ^ (((ob >> 9) & 1) << 5)); }
__host__ __device__ __forceinline__ void stage_rc(int b, int& R, int& C) { const int st = b / 1024, sb = b % 1024, swz = sb ^ (((sb >> 9) & 1) << 5); R = (st >> 1) * 16 + swz / 64; C = (st & 1) * 32 + (swz % 64) / 2; }
__host__ __device__ __forceinline__ int perm32(int rho) { const int n = rho >> 4, i = rho & 15; return 8 * (i >> 2) + 4 * n + (i & 3); }

struct Unit { int pm, pn; };
struct Gemm { const bf16_t* A; const bf16_t* Bt; int M, N, K; };

struct StaticOrder {
    int nM, nN, nwg, G, c;
    __host__ __device__ void init(int M, int N, int G_, int c_) { nM = M / BM; nN = N / BM; nwg = nM * nN; G = G_; c = c_; }
    __host__ __device__ bool next(int i, Unit& u) const {
        const long L = (long)i * G + c; if (L >= nwg) return false;
        int wgid = (int)L; { const int q = nwg / NXCD, r = nwg % NXCD, xcd = wgid % NXCD, off = wgid / NXCD; wgid = (xcd < r ? xcd * (q + 1) : r * (q + 1) + (xcd - r) * q) + off; }
        const int nig = WGM * nN, gid = wgid / nig, fm = gid * WGM, gsz = (nM - fm) < WGM ? (nM - fm) : WGM;
        u.pm = fm + ((wgid % nig) % gsz); u.pn = (wgid % nig) / gsz; return true;
    }
    __device__ __forceinline__ void a_ready(const Unit&) const {}
    __device__ __forceinline__ void done(const Unit&) const {}
};

__device__ __forceinline__ unsigned cvt_pk_bf16(float lo, float hi) { unsigned r; asm volatile("v_cvt_pk_bf16_f32 %0, %1, %2" : "=v"(r) : "v"(lo), "v"(hi)); return r; }
typedef float f32x2 __attribute__((ext_vector_type(2)));
template <class Epi, class Sched, bool ALIGN_EPI = false, bool SP2 = false>
__device__ __forceinline__ void gemm_phase(PG8_LAS unsigned char* lds, const Gemm g, const Sched& S, const Epi& E) {
    int tid_l = threadIdx.x; asm volatile("" : "+v"(tid_l)); const int tid = tid_l, wid = __builtin_amdgcn_readfirstlane(tid >> 6), lane = tid & 63, wr = wid >> 2, wc = wid & 3, fr = lane & 15, fq = lane >> 4;
    const int K = g.K, nt = K / BK;
    unsigned voffA[2], voffB[2];
#pragma unroll
    for (int i = 0; i < 2; ++i) { int R, C; stage_rc(tid * 16 + i * 8192, R, C); const int Rb = Epi::PERM ? ((R & ~31) + perm32(R & 31)) : R;
        voffA[i] = (unsigned)(R * K + C) * 2u; voffB[i] = (unsigned)(Rb * K + C) * 2u; }
    const size_t kstep = (size_t)(BK * 2);
    const size_t hstep = (size_t)HALF * K * 2;
    const size_t tstep = 2 * hstep;
    const unsigned ldsw = (unsigned)wid * 1024u;
    const int aoff = lds_byte(wr * 64 + fr, fq * 8), boff = lds_byte(wc * 32 + fr, fq * 8);
#define PG8_SA(b, h) (((b) * 2 + (h)) * HTB)
#define PG8_SB(b, h) ((4 + (b) * 2 + (h)) * HTB)
#define PG8_STAGE(bufoff, gbase, voff) do { _Pragma("unroll") for (int _i = 0; _i < 2; ++_i) \
        __builtin_amdgcn_global_load_lds((const unsigned*)((const char*)(gbase) + (voff)[_i]), (PG8_LAS unsigned*)(lds + (bufoff) + ldsw + _i * 8192), 16, 0, 0); } while (0)
#define PG8_LDA(dst, b, h) do { _Pragma("unroll") for (int m = 0; m < 4; ++m) _Pragma("unroll") for (int k = 0; k < 2; ++k) dst[m][k] = *(const PG8_LAS bf16x8*)(lds + PG8_SA(b, h) + aoff + m * 2048 + k * 1024); } while (0)
#define PG8_LDB(dst, b, h) do { _Pragma("unroll") for (int n = 0; n < 2; ++n) _Pragma("unroll") for (int k = 0; k < 2; ++k) dst[n][k] = *(const PG8_LAS bf16x8*)(lds + PG8_SB(b, h) + boff + n * 2048 + k * 1024); } while (0)
#define PG8_MMA(ai, bj, At, Bt) do { __builtin_amdgcn_s_setprio(1); _Pragma("unroll") for (int m = 0; m < 4; ++m) _Pragma("unroll") for (int n = 0; n < 2; ++n) _Pragma("unroll") for (int k = 0; k < 2; ++k) \
        acc[ai][bj][m][n] = __builtin_amdgcn_mfma_f32_16x16x32_bf16(Bt[n][k], At[m][k], acc[ai][bj][m][n], 0, 0, 0); __builtin_amdgcn_s_setprio(0); } while (0)
#define PG8_WAIT_V(n) asm volatile("s_waitcnt vmcnt(" #n ")" ::: "memory")
#define PG8_WAIT_L(n) asm volatile("s_waitcnt lgkmcnt(" #n ")" ::: "memory")
#define PG8_BAR __builtin_amdgcn_s_barrier()
#define PG8_SCHED __builtin_amdgcn_sched_barrier(0)
    Unit cur, nxt; int ui = 0;
    if (!S.next(0, cur)) return;
    f32x4 acc[2][2][4][2];
#pragma unroll
    for (int a = 0; a < 2; ++a)
#pragma unroll
        for (int b = 0; b < 2; ++b)
#pragma unroll
            for (int m = 0; m < 4; ++m)
#pragma unroll
                for (int n = 0; n < 2; ++n) acc[a][b][m][n] = (f32x4){0.f, 0.f, 0.f, 0.f};
    bf16x8 At[4][2], B0[2][2], B1[2][2];
    const char* cA = (const char*)g.A + (size_t)cur.pm * tstep; const char* cB = (const char*)g.Bt + (size_t)cur.pn * tstep;
    S.a_ready(cur);
    if constexpr (SP2) {
        PG8_STAGE(PG8_SB(0, 0), cB, voffB); PG8_STAGE(PG8_SB(0, 1), cB + hstep, voffB); PG8_STAGE(PG8_SA(0, 0), cA, voffA); PG8_STAGE(PG8_SA(0, 1), cA + hstep, voffA);
        if (wr == 1) PG8_BAR;
        PG8_WAIT_V(2); PG8_BAR;
        PG8_STAGE(PG8_SB(1, 0), cB + kstep, voffB); PG8_STAGE(PG8_SA(1, 0), cA + kstep, voffA); PG8_STAGE(PG8_SB(1, 1), cB + hstep + kstep, voffB);
        PG8_WAIT_V(6); PG8_BAR;
    } else {
        PG8_STAGE(PG8_SB(0, 0), cB, voffB); PG8_STAGE(PG8_SA(0, 0), cA, voffA); PG8_STAGE(PG8_SB(0, 1), cB + hstep, voffB); PG8_STAGE(PG8_SA(0, 1), cA + hstep, voffA);
        if (wr == 1) PG8_BAR;
        PG8_WAIT_V(4); PG8_BAR;
        PG8_STAGE(PG8_SB(1, 0), cB + kstep, voffB); PG8_STAGE(PG8_SA(1, 0), cA + kstep, voffA); PG8_STAGE(PG8_SB(1, 1), cB + hstep + kstep, voffB);
        PG8_WAIT_V(6); PG8_BAR;
    }
    for (;;) {
        const bool has_next = S.next(ui + 1, nxt);
        const char* nA = has_next ? (const char*)g.A + (size_t)nxt.pm * tstep : cA; const char* nB = has_next ? (const char*)g.Bt + (size_t)nxt.pn * tstep : cB;
        for (int t = 0; t < nt; t += 2) {
            const bool last = (t == nt - 2);
            const char* a1 = cA + (size_t)(t + 1) * kstep;
            const char* a2 = last ? nA : cA + (size_t)(t + 2) * kstep; const char* b2 = last ? nB : cB + (size_t)(t + 2) * kstep;
            const char* a3 = a2 + kstep; const char* b3 = b2 + kstep;
            if (last && has_next) S.a_ready(nxt);
            if constexpr (SP2) {
            PG8_LDB(B0, 0, 0); PG8_LDB(B1, 0, 1); PG8_SCHED; PG8_LDA(At, 0, 0); PG8_STAGE(PG8_SA(1, 1), a1 + hstep, voffA);
            PG8_WAIT_V(8); PG8_WAIT_L(0); PG8_BAR; PG8_MMA(0, 0, At, B0); PG8_MMA(0, 1, At, B1); PG8_BAR; PG8_SCHED;
            PG8_LDA(At, 0, 1); PG8_STAGE(PG8_SB(0, 0), b2, voffB); PG8_STAGE(PG8_SB(0, 1), b2 + hstep, voffB); PG8_STAGE(PG8_SA(0, 0), a2, voffA);
            PG8_WAIT_V(8); PG8_WAIT_L(0); PG8_BAR; PG8_MMA(1, 0, At, B0); PG8_MMA(1, 1, At, B1); PG8_BAR; PG8_SCHED;
            PG8_LDB(B0, 1, 0); PG8_LDB(B1, 1, 1); PG8_SCHED; PG8_LDA(At, 1, 0); PG8_STAGE(PG8_SA(0, 1), a2 + hstep, voffA);
            PG8_WAIT_V(8); PG8_WAIT_L(0); PG8_BAR; PG8_MMA(0, 0, At, B0); PG8_MMA(0, 1, At, B1); PG8_BAR; PG8_SCHED;
            PG8_LDA(At, 1, 1); PG8_STAGE(PG8_SB(1, 0), b3, voffB); PG8_STAGE(PG8_SB(1, 1), b3 + hstep, voffB); PG8_STAGE(PG8_SA(1, 0), a3, voffA);
            PG8_WAIT_V(8); PG8_WAIT_L(0); PG8_BAR; PG8_MMA(1, 0, At, B0); PG8_MMA(1, 1, At, B1); PG8_BAR; PG8_SCHED;
            } else {
            PG8_LDB(B0, 0, 0); PG8_SCHED; PG8_LDA(At, 0, 0); PG8_STAGE(PG8_SA(1, 1), a1 + hstep, voffA);
            PG8_WAIT_L(8); PG8_BAR; PG8_WAIT_L(0); PG8_MMA(0, 0, At, B0); PG8_BAR; PG8_SCHED;
            PG8_LDB(B1, 0, 1); PG8_STAGE(PG8_SB(0, 0), b2, voffB);
            PG8_BAR; PG8_WAIT_L(0); PG8_MMA(0, 1, At, B1); PG8_BAR;
            PG8_LDA(At, 0, 1); PG8_STAGE(PG8_SA(0, 0), a2, voffA);
            PG8_BAR; PG8_WAIT_L(0); PG8_MMA(1, 0, At, B0); PG8_BAR; PG8_SCHED;
            PG8_STAGE(PG8_SB(0, 1), b2 + hstep, voffB);
            PG8_WAIT_V(6); PG8_BAR; PG8_MMA(1, 1, At, B1); PG8_BAR;
            PG8_LDB(B0, 1, 0); PG8_SCHED; PG8_LDA(At, 1, 0); PG8_STAGE(PG8_SA(0, 1), a2 + hstep, voffA);
            PG8_WAIT_L(8); PG8_BAR; PG8_WAIT_L(0); PG8_MMA(0, 0, At, B0); PG8_BAR; PG8_SCHED;
            PG8_LDB(B1, 1, 1); PG8_STAGE(PG8_SB(1, 0), b3, voffB);
            PG8_BAR; PG8_WAIT_L(0); PG8_MMA(0, 1, At, B1); PG8_BAR;
            PG8_LDA(At, 1, 1); PG8_STAGE(PG8_SA(1, 0), a3, voffA);
            PG8_BAR; PG8_WAIT_L(0); PG8_MMA(1, 0, At, B0); PG8_BAR; PG8_SCHED;
            PG8_STAGE(PG8_SB(1, 1), b3 + hstep, voffB);
            PG8_WAIT_V(6); PG8_BAR; PG8_MMA(1, 1, At, B1); PG8_BAR;
            }
        }
        if constexpr (ALIGN_EPI) { if (wr == 0) PG8_BAR; }
        if constexpr (!Epi::AFTER_DRAIN) { E(acc, cur, wr, wc, fr, fq); S.done(cur); }
        if (!has_next) break;
#pragma unroll
        for (int a = 0; a < 2; ++a)
#pragma unroll
            for (int b = 0; b < 2; ++b)
#pragma unroll
                for (int m = 0; m < 4; ++m)
#pragma unroll
                    for (int n = 0; n < 2; ++n) acc[a][b][m][n] = (f32x4){0.f, 0.f, 0.f, 0.f};
        cur = nxt; cA = nA; cB = nB; ++ui;
        if constexpr (ALIGN_EPI) { if (wr == 1) PG8_BAR; }
    }
    PG8_WAIT_V(0);
    if constexpr (!ALIGN_EPI) { if (wr == 0) PG8_BAR; }
    PG8_BAR;
    if constexpr (Epi::AFTER_DRAIN) { E.fused(acc, cur, wr, wc, fr, fq, lds, wid, lane); S.done(cur); }
#undef PG8_SA
#undef PG8_SB
#undef PG8_STAGE
#undef PG8_LDA
#undef PG8_LDB
#undef PG8_MMA
#undef PG8_WAIT_V
#undef PG8_WAIT_L
#undef PG8_BAR
#undef PG8_SCHED
}
}

constexpr int NB = 16, SEQ = 4096, DM = 1024, DFF = 2816, T = NB * SEQ, NMOD = 9216;
constexpr float ALPHA_F = 1.41421356237309515f;
constexpr float LN_EPS_F = 1e-5f, RMS_EPS_F = 1e-6f;
constexpr size_t MiB = 1u << 20;
constexpr size_t OFF_MOD = 1 * MiB;
constexpr size_t OFF_STATS = 3 * MiB;
constexpr size_t OFF_LSE = 8 * MiB;
constexpr size_t OFF_W1 = 12 * MiB;
constexpr size_t OFF_W2 = 56 * MiB;
constexpr size_t OFF_WM = 78 * MiB;
constexpr size_t OFF_WMO = 85 * MiB;
constexpr size_t OFF_WA = 87 * MiB;
constexpr size_t OFF_WAO = 105 * MiB;
constexpr size_t OFF_H = 108 * MiB;
constexpr size_t OFF_Y = 236 * MiB;
constexpr size_t OFF_R = 364 * MiB;
constexpr size_t WS_END = 940 * MiB;
constexpr int LDS_BYTES = 135168;

typedef unsigned short bf16_t;
typedef short bf16x8 __attribute__((ext_vector_type(8)));
typedef float f32x4 __attribute__((ext_vector_type(4)));
typedef float f32x2 __attribute__((ext_vector_type(2)));
typedef unsigned u32x4 __attribute__((ext_vector_type(4)));
typedef unsigned u32x2 __attribute__((ext_vector_type(2)));
typedef short s16x4 __attribute__((ext_vector_type(4)));
#define LASQ __attribute__((address_space(3)))

__device__ __forceinline__ unsigned f2bf(float f) { unsigned u = __float_as_uint(f); return (u + 0x7fffu + ((u >> 16) & 1u)) >> 16; }
__device__ __forceinline__ unsigned pk2(float lo, float hi) { return pg8::cvt_pk_bf16(lo, hi); }
__device__ __forceinline__ float bf2f(unsigned short h) { return __uint_as_float(((unsigned)h) << 16); }
__device__ __forceinline__ float bflo(unsigned w) { return __uint_as_float(w << 16); }
__device__ __forceinline__ float bfhi(unsigned w) { return __uint_as_float(w & 0xffff0000u); }
__device__ __forceinline__ float wave_sum(float v) {
#pragma unroll
    for (int o = 1; o < 64; o <<= 1) v += __shfl_xor(v, o);
    return v;
}
__device__ __forceinline__ float wave_max(float v) {
#pragma unroll
    for (int o = 1; o < 64; o <<= 1) v = fmaxf(v, __shfl_xor(v, o));
    return v;
}
__device__ __forceinline__ float silu_f(float g) { return g * __builtin_amdgcn_rcpf(1.f + __expf(-g)); }
__device__ __forceinline__ float sigmoid_f(float g) { return __builtin_amdgcn_rcpf(1.f + __expf(-g)); }

struct Args { const float* in[15]; float* out; unsigned char* ws; int ph_lo, ph_hi; };

struct EpiSwiGLU {
    static constexpr bool PERM = true, AFTER_DRAIN = false;
    bf16_t* act;
    __device__ __forceinline__ void operator()(const f32x4 (&acc)[2][2][4][2], const pg8::Unit& u, int wr, int wc, int fr, int fq) const {
        const int row0 = u.pm * 256 + wr * 64 + fr, col0 = u.pn * 128 + wc * 32 + 8 * fq;
#pragma unroll
        for (int ai = 0; ai < 2; ++ai)
#pragma unroll
            for (int m = 0; m < 4; ++m) {
                bf16_t* p = act + (size_t)(row0 + ai * 128 + m * 16) * DFF + col0;
                const f32x4 g0 = acc[ai][0][m][0], g1 = acc[ai][0][m][1], u0 = acc[ai][1][m][0], u1 = acc[ai][1][m][1];
                u32x4 w;
                w.x = pk2(silu_f(g0[0]) * u0[0], silu_f(g0[1]) * u0[1]); w.y = pk2(silu_f(g0[2]) * u0[2], silu_f(g0[3]) * u0[3]);
                w.z = pk2(silu_f(g1[0]) * u1[0], silu_f(g1[1]) * u1[1]); w.w = pk2(silu_f(g1[2]) * u1[2], silu_f(g1[3]) * u1[3]);
                *(u32x4*)p = w;
            }
    }
};
struct EpiResidual {
    static constexpr bool PERM = false, AFTER_DRAIN = false;
    const float* vin; float* vout; const float* stats; const float* lng; const float* lnb; const float* gate; float wgt; int has_ln;
    __device__ __forceinline__ void operator()(const f32x4 (&acc)[2][2][4][2], const pg8::Unit& u, int wr, int wc, int fr, int fq) const {
        const int b = (u.pm * 256) >> 12;
        const int colb = u.pn * 256 + wc * 32 + 4 * fq;
        const float* gp = gate + (size_t)b * NMOD + colb;
#pragma unroll
        for (int bj = 0; bj < 2; ++bj)
#pragma unroll
            for (int n = 0; n < 2; ++n) {
                const int co = bj * 128 + n * 16;
                f32x4 gt = *(const f32x4*)(gp + co); gt = (gt + 1.0f) * wgt;
                f32x4 lg = (f32x4){ALPHA_F, ALPHA_F, ALPHA_F, ALPHA_F}, lb = (f32x4){0.f, 0.f, 0.f, 0.f};
                if (has_ln) { lg = *(const f32x4*)(lng + colb + co) * ALPHA_F; lb = *(const f32x4*)(lnb + colb + co) * ALPHA_F; }
#pragma unroll
                for (int ai = 0; ai < 2; ++ai)
#pragma unroll
                    for (int m = 0; m < 4; ++m) {
                        const int row = u.pm * 256 + ai * 128 + wr * 64 + m * 16 + fr;
                        const size_t off = (size_t)row * DM + colb + co;
                        f32x4 x = *(const f32x4*)(vin + off);
                        if (has_ln) { const f32x2 st = *(const f32x2*)(stats + 2 * (size_t)row); x = (x - st.x) * st.y; }
                        const f32x4 o = x * lg + lb + gt * acc[ai][bj][m][n];
                        *(f32x4*)(vout + off) = o;
                    }
            }
    }
};
struct EpiStoreBf16 {
    static constexpr bool PERM = true, AFTER_DRAIN = false;
    bf16_t* O; int ldc;
    __device__ __forceinline__ void operator()(const f32x4 (&acc)[2][2][4][2], const pg8::Unit& u, int wr, int wc, int fr, int fq) const {
        const int row0 = u.pm * 256 + wr * 64 + fr, col0 = u.pn * 256 + wc * 32 + 8 * fq;
#pragma unroll
        for (int ai = 0; ai < 2; ++ai)
#pragma unroll
            for (int m = 0; m < 4; ++m) {
                bf16_t* p = O + (size_t)(row0 + ai * 128 + m * 16) * ldc + col0;
#pragma unroll
                for (int bj = 0; bj < 2; ++bj) {
                    const f32x4 v0 = acc[ai][bj][m][0], v1 = acc[ai][bj][m][1];
                    u32x4 w; w.x = pk2(v0[0], v0[1]); w.y = pk2(v0[2], v0[3]); w.z = pk2(v1[0], v1[1]); w.w = pk2(v1[2], v1[3]);
                    *(u32x4*)(p + bj * 128) = w;
                }
            }
    }
};

__device__ __forceinline__ void transpose_item(const float* W, int K, int N, bf16_t* WT, int item, int nblk, bool perm_w1, bool qscale, float* scr, int lane) {
    const int kb = item / nblk, nb = item % nblk, k0 = 64 * kb, n0 = 32 * nb;
    const int ncol = n0 + (lane & 31);
#pragma unroll 8
    for (int i = 0; i < 32; ++i) { const int kk = 2 * i + (lane >> 5); scr[kk * 33 + (lane & 31)] = (ncol < N) ? W[(size_t)(k0 + kk) * N + ncol] : 0.f; }
    asm volatile("s_waitcnt lgkmcnt(0)" ::: "memory");
    int rbase = n0;
    if (perm_w1) rbase = (n0 < DFF) ? 256 * (n0 >> 7) + (n0 & 127) : 256 * ((n0 - DFF) >> 7) + 128 + ((n0 - DFF) & 127);
    const int c = lane & 7;
    const float sc = (qscale && (n0 % 3072) < 1024) ? 0.08838834764831845f * 1.4426950408889634f : 1.0f;
#pragma unroll
    for (int j = 0; j < 4; ++j) {
        const int n = (lane >> 3) + 8 * j; const float* s = scr + (8 * c) * 33 + n;
        u32x4 o; o.x = pk2(s[0 * 33] * sc, s[1 * 33] * sc); o.y = pk2(s[2 * 33] * sc, s[3 * 33] * sc); o.z = pk2(s[4 * 33] * sc, s[5 * 33] * sc); o.w = pk2(s[6 * 33] * sc, s[7 * 33] * sc);
        *(u32x4*)(WT + (size_t)(rbase + n) * K + k0 + 8 * c) = o;
    }
    asm volatile("s_waitcnt lgkmcnt(0)" ::: "memory");
}

__device__ __forceinline__ void p0_phase(const Args& a, unsigned char* lds, int tid, int lane, int wave) {
    float* sc = (float*)lds;
    float* red = (float*)(lds + 65536);
    const float* cin = a.in[1];
    for (int i = tid; i < 16 * 1024; i += 512) { const float v = cin[i]; sc[i] = silu_f(v); }
    __syncthreads();
    float* mod = (float*)(a.ws + OFF_MOD);
    for (int item = blockIdx.x; item < 288; item += gridDim.x) {
        const int l = item / 144, n0 = (item % 144) * 64;
        const float* W = a.in[2] + (size_t)l * 1024 * NMOD + n0 + lane;
        float acc[16];
#pragma unroll
        for (int b = 0; b < 16; ++b) acc[b] = 0.f;
        const int kb = wave * 128;
#pragma unroll 2
        for (int k = kb; k < kb + 128; k += 4) {
            const float w0 = W[(size_t)k * NMOD], w1 = W[(size_t)(k + 1) * NMOD], w2 = W[(size_t)(k + 2) * NMOD], w3 = W[(size_t)(k + 3) * NMOD];
#pragma unroll
            for (int b = 0; b < 16; ++b) { const f32x4 s = *(const f32x4*)(sc + b * 1024 + k); acc[b] += s[0] * w0 + s[1] * w1 + s[2] * w2 + s[3] * w3; }
        }
#pragma unroll
        for (int b = 0; b < 16; ++b) red[(wave * 16 + b) * 64 + lane] = acc[b];
        __syncthreads();
        for (int o = tid; o < 1024; o += 512) {
            const int b = o >> 6, n = o & 63; float s = 0.f;
#pragma unroll
            for (int w = 0; w < 8; ++w) s += red[(w * 16 + b) * 64 + n];
            mod[(size_t)(l * 16 + b) * NMOD + n0 + n] = s + a.in[3][l * NMOD + n0 + n];
        }
        __syncthreads();
    }
    float* scr = (float*)(lds + wave * 8448);
    const int gw = blockIdx.x * 8 + wave, NGW = gridDim.x * 8;
    constexpr int I_W1 = 16 * 176, I_W2 = 44 * 32, I_WM = 16 * 97, I_SQ = 16 * 32, I_WA = 16 * 288;
    constexpr int NITEMS = 4 * I_W1 + 4 * I_W2 + I_WM + I_SQ + I_WA + I_SQ;
    for (int it = gw; it < NITEMS; it += NGW) {
        int r = it;
        if (r < 4 * I_W1) { const int mi = r / I_W1; transpose_item(a.in[6] + (size_t)mi * 1024 * 5632, 1024, 5632, (bf16_t*)(a.ws + OFF_W1) + (size_t)mi * 5632 * 1024, r % I_W1, 176, true, false, scr, lane); continue; } r -= 4 * I_W1;
        if (r < 4 * I_W2) { const int mi = r / I_W2; transpose_item(a.in[7] + (size_t)mi * 2816 * 1024, 2816, 1024, (bf16_t*)(a.ws + OFF_W2) + (size_t)mi * 1024 * 2816, r % I_W2, 32, false, false, scr, lane); continue; } r -= 4 * I_W2;
        if (r < I_WM) { transpose_item(a.in[8], 1024, 3088, (bf16_t*)(a.ws + OFF_WM), r, 97, false, false, scr, lane); continue; } r -= I_WM;
        if (r < I_SQ) { transpose_item(a.in[12], 1024, 1024, (bf16_t*)(a.ws + OFF_WMO), r, 32, false, false, scr, lane); continue; } r -= I_SQ;
        if (r < I_WA) { transpose_item(a.in[13], 1024, 9216, (bf16_t*)(a.ws + OFF_WA), r, 288, false, true, scr, lane); continue; } r -= I_WA;
        transpose_item(a.in[14], 1024, 1024, (bf16_t*)(a.ws + OFF_WAO), r, 32, false, false, scr, lane);
    }
    for (int row = 3104 + gw; row < 3328; row += NGW) {
        u32x4* p = (u32x4*)((bf16_t*)(a.ws + OFF_WM) + (size_t)row * 1024);
        p[lane] = (u32x4){0u, 0u, 0u, 0u}; p[64 + lane] = (u32x4){0u, 0u, 0u, 0u};
    }
}

__device__ __forceinline__ void lnmod_phase(const float* vin, int has_ln, const float* lng, const float* lnb, const float* modl, int s,
                                            bf16_t* hout, float* stats, int lane, int wave) {
    const int gw = blockIdx.x * 8 + wave, NGW = gridDim.x * 8;
    const int NG = T / 4, gpw = (NG + NGW - 1) / NGW;
    for (int gi = gw * gpw; gi < (gw + 1) * gpw && gi < NG; ++gi) {
        const int m0 = gi * 4, b = m0 >> 12;
        f32x4 v[4][4];
#pragma unroll
        for (int r = 0; r < 4; ++r) {
            const f32x4* xr = (const f32x4*)(vin + (size_t)(m0 + r) * DM) + lane;
#pragma unroll
            for (int j = 0; j < 4; ++j) v[r][j] = xr[64 * j];
        }
        const f32x4* shp = (const f32x4*)(modl + (size_t)b * NMOD + (s * 3 + 0) * DM) + lane;
        const f32x4* scp = (const f32x4*)(modl + (size_t)b * NMOD + (s * 3 + 1) * DM) + lane;
        f32x4 sc4[4], sh4[4];
#pragma unroll
        for (int j = 0; j < 4; ++j) { sc4[j] = scp[64 * j] + 1.0f; sh4[j] = shp[64 * j]; }
        if (has_ln) {
            f32x4 g4[4], b4[4];
#pragma unroll
            for (int j = 0; j < 4; ++j) { g4[j] = ((const f32x4*)lng)[lane + 64 * j]; b4[j] = ((const f32x4*)lnb)[lane + 64 * j]; }
#pragma unroll
            for (int j = 0; j < 4; ++j) { sh4[j] = b4[j] * sc4[j] + sh4[j]; sc4[j] = g4[j] * sc4[j]; }
#pragma unroll
            for (int r = 0; r < 4; ++r) {
                float sm = 0.f;
#pragma unroll
                for (int j = 0; j < 4; ++j) sm += (v[r][j][0] + v[r][j][1]) + (v[r][j][2] + v[r][j][3]);
                const float mean = wave_sum(sm) * (1.f / DM); float s2 = 0.f;
#pragma unroll
                for (int j = 0; j < 4; ++j) { v[r][j] = v[r][j] - mean; s2 += (v[r][j][0] * v[r][j][0] + v[r][j][1] * v[r][j][1]) + (v[r][j][2] * v[r][j][2] + v[r][j][3] * v[r][j][3]); }
                const float rstd = 1.f / sqrtf(wave_sum(s2) * (1.f / DM) + LN_EPS_F);
                if (lane == 0) *(f32x2*)(stats + 2 * (size_t)(m0 + r)) = (f32x2){mean, rstd};
#pragma unroll
                for (int j = 0; j < 4; ++j) v[r][j] = v[r][j] * rstd;
            }
        }
#pragma unroll
        for (int r = 0; r < 4; ++r) {
            u32x2* o8 = (u32x2*)(hout + (size_t)(m0 + r) * DM) + lane;
#pragma unroll
            for (int j = 0; j < 4; ++j) {
                const f32x4 h = v[r][j] * sc4[j] + sh4[j];
                o8[64 * j] = (u32x2){pk2(h[0], h[1]), pk2(h[2], h[3])};
            }
        }
    }
}
__device__ __forceinline__ void final_ln_phase(float* v_io, const float* lng, const float* lnb, int lane, int wave) {
    const int gw = blockIdx.x * 8 + wave, NGW = gridDim.x * 8;
    const int NG = T / 4, gpw = (NG + NGW - 1) / NGW;
    for (int gi = gw * gpw; gi < (gw + 1) * gpw && gi < NG; ++gi) {
        const int m0 = gi * 4;
        f32x4 v[4][4];
#pragma unroll
        for (int r = 0; r < 4; ++r) {
            const f32x4* xr = (const f32x4*)(v_io + (size_t)(m0 + r) * DM) + lane;
#pragma unroll
            for (int j = 0; j < 4; ++j) v[r][j] = xr[64 * j];
        }
        f32x4 g4[4], b4[4];
#pragma unroll
        for (int j = 0; j < 4; ++j) { g4[j] = ((const f32x4*)lng)[lane + 64 * j]; b4[j] = ((const f32x4*)lnb)[lane + 64 * j]; }
#pragma unroll
        for (int r = 0; r < 4; ++r) {
            float sm = 0.f;
#pragma unroll
            for (int j = 0; j < 4; ++j) sm += (v[r][j][0] + v[r][j][1]) + (v[r][j][2] + v[r][j][3]);
            const float mean = wave_sum(sm) * (1.f / DM); float s2 = 0.f;
#pragma unroll
            for (int j = 0; j < 4; ++j) { v[r][j] = v[r][j] - mean; s2 += (v[r][j][0] * v[r][j][0] + v[r][j][1] * v[r][j][1]) + (v[r][j][2] * v[r][j][2] + v[r][j][3] * v[r][j][3]); }
            const float rstd = 1.f / sqrtf(wave_sum(s2) * (1.f / DM) + LN_EPS_F);
            f32x4* xo = (f32x4*)(v_io + (size_t)(m0 + r) * DM) + lane;
#pragma unroll
            for (int j = 0; j < 4; ++j) xo[64 * j] = v[r][j] * rstd * g4[j] + b4[j];
        }
    }
}

__device__ __forceinline__ bf16x8 lds_b128(const unsigned char* p) { return *(const bf16x8*)p; }
__device__ __forceinline__ void mlstm_phase(const Args& a, unsigned char* lds, int tid, int lane, int wave) {
    const bf16_t* P = (const bf16_t*)(a.ws + OFF_R);
    constexpr int PLD = 3328;
    bf16_t* Y = (bf16_t*)(a.ws + OFF_Y);
    const float* gbias = a.in[9]; const float* convw = a.in[10]; const float* gain = a.in[11];
    unsigned char* Qs = lds;
    unsigned char* Ks = lds + 9216;
    unsigned char* KwT = lds + 18432;
    unsigned char* VsT = lds + 27648;
    unsigned char* Cb = lds + 46080;
    unsigned char* Pm = lds + 64512;
    float* fl = (float*)(lds + 81920);
    float* rowT = fl;
    float* colT = fl + 64;
    float* mL = fl + 128;
    float* nL = fl + 192;
    float* denL = fl + 256;
    float* ssqL = fl + 320;
    const int fr = lane & 15, fq = lane >> 4;
    const int it = wave >> 1, wh = wave & 1;
    for (int unit = blockIdx.x; unit < 128; unit += gridDim.x) {
        const int b = unit >> 3, h = unit & 7;
        f32x4 Cacc[4];
#pragma unroll
        for (int kt = 0; kt < 4; ++kt) Cacc[kt] = (f32x4){0.f, 0.f, 0.f, 0.f};
        float nreg = 0.f, m_prev = 0.f;
        __syncthreads();
        for (int i = tid; i < 128 * 72 / 2; i += 512) ((unsigned*)Cb)[i] = 0u;
        if (tid < 64) nL[tid] = 0.f;
        const int isk = wave & 1, kk = lane, tq = wave >> 1;
        const int gcol = isk * 512 + h * 64 + kk;
        const float cw0 = convw[gcol], cw1 = convw[1024 + gcol], cw2 = convw[2048 + gcol], cw3 = convw[3072 + gcol];
        const float gb_i = gbias[h], gb_f = gbias[8 + h];
        for (int c = 0; c < 64; ++c) {
            const int t0 = c * 64; const size_t rowbase = (size_t)b * SEQ + t0;
            const float ig = bf2f(P[(rowbase + lane) * PLD + 3072 + h]) + gb_i;
            const float fp = bf2f(P[(rowbase + lane) * PLD + 3080 + h]) + gb_f;
            const float lf = fminf(fp, 0.f) - log1pf(__expf(-fabsf(fp)));
            float bc = lf;
#pragma unroll
            for (int o = 1; o < 64; o <<= 1) { const float t = __shfl_up(bc, o); if (lane >= o) bc += t; }
            const float blast = __shfl(bc, 63);
            const float av = blast - bc + ig;
            const float mloc = wave_max(av);
            const float mnew = fmaxf(blast + m_prev, mloc);
            const float sp = __expf(blast + m_prev - mnew);
            const float wa = __expf(av - mnew);
            float pmx = ig - bc;
#pragma unroll
            for (int o = 1; o < 64; o <<= 1) { const float t = __shfl_up(pmx, o); if (lane >= o) pmx = fmaxf(pmx, t); }
            const float mi = fmaxf(bc + m_prev, bc + pmx);
            const float iw = __expf(bc + m_prev - mi);
            if (wave == 0) { rowT[lane] = bc - mi; colT[lane] = ig - bc; mL[lane] = mi; }
            {
                float x[19];
                const bf16_t* pu = P + (size_t)b * SEQ * PLD;
#pragma unroll
                for (int e = 0; e < 19; ++e) {
                    const int tt = t0 + 16 * tq - 3 + e;
                    const unsigned off = (unsigned)(tt < 0 ? 0 : tt) * (unsigned)PLD + (unsigned)gcol;
                    const float xv = bf2f(pu[off]);
                    x[e] = (tt >= 0) ? xv : 0.f;
                }
#pragma unroll
                for (int e = 0; e < 16; ++e) {
                    const int j = 16 * tq + e;
                    float y = cw0 * x[e] + cw1 * x[e + 1] + cw2 * x[e + 2] + cw3 * x[e + 3];
                    y = silu_f(y);
                    if (!isk) {
                        const float qs = y * 0.125f; const float iwj = __shfl(iw, j);
                        *(bf16_t*)(Qs + (j * 72 + kk) * 2) = (bf16_t)f2bf(qs);
                        *(bf16_t*)(Pm + (j * 136 + 64 + kk) * 2) = (bf16_t)f2bf(iwj * qs);
                    } else {
                        const float waj = __shfl(wa, j);
                        *(bf16_t*)(Ks + (j * 72 + kk) * 2) = (bf16_t)f2bf(y);
                        *(bf16_t*)(KwT + (kk * 72 + j) * 2) = (bf16_t)f2bf(waj * y);
                    }
                }
                const u32x4* vp = (const u32x4*)(P + (rowbase + lane) * PLD + 1024 + h * 128 + 16 * wave);
                const u32x4 va = vp[0], vb = vp[1];
                const unsigned vw[8] = {va.x, va.y, va.z, va.w, vb.x, vb.y, vb.z, vb.w};
#pragma unroll
                for (int e = 0; e < 8; ++e) {
                    *(bf16_t*)(VsT + ((16 * wave + 2 * e) * 72 + lane) * 2) = (bf16_t)(vw[e] & 0xffffu);
                    *(bf16_t*)(VsT + ((16 * wave + 2 * e + 1) * 72 + lane) * 2) = (bf16_t)(vw[e] >> 16);
                }
            }
            __syncthreads();
#pragma unroll
            for (int jj2 = 0; jj2 < 2; ++jj2) {
                const int jt = 2 * wh + jj2;
                f32x4 s = (f32x4){0.f, 0.f, 0.f, 0.f};
#pragma unroll
                for (int ks = 0; ks < 2; ++ks) {
                    const bf16x8 kf = lds_b128(Ks + ((16 * jt + fr) * 72 + 32 * ks + 8 * fq) * 2);
                    const bf16x8 qf = lds_b128(Qs + ((16 * it + fr) * 72 + 32 * ks + 8 * fq) * 2);
                    s = __builtin_amdgcn_mfma_f32_16x16x32_bf16(kf, qf, s, 0, 0, 0);
                }
                const int i = 16 * it + fr; const float rt = rowT[i];
                float p[4];
#pragma unroll
                for (int e = 0; e < 4; ++e) { const int j = 16 * jt + 4 * fq + e; p[e] = (j <= i) ? s[e] * __expf(rt + colT[j]) : 0.f; }
                *(u32x2*)(Pm + (i * 136 + 16 * jt + 4 * fq) * 2) = (u32x2){pk2(p[0], p[1]), pk2(p[2], p[3])};
            }
            __syncthreads();
            f32x4 nacc[4];
#pragma unroll
            for (int v4 = 0; v4 < 4; ++v4) {
                const int vt = 4 * wh + v4; f32x4 acc = (f32x4){0.f, 0.f, 0.f, 0.f};
#pragma unroll
                for (int ks = 0; ks < 4; ++ks) {
                    const bf16x8 af = (ks < 2) ? lds_b128(VsT + ((16 * vt + fr) * 72 + 32 * ks + 8 * fq) * 2)
                                               : lds_b128(Cb + ((16 * vt + fr) * 72 + 32 * (ks - 2) + 8 * fq) * 2);
                    const bf16x8 bfr = lds_b128(Pm + ((16 * it + fr) * 136 + 32 * ks + 8 * fq) * 2);
                    acc = __builtin_amdgcn_mfma_f32_16x16x32_bf16(af, bfr, acc, 0, 0, 0);
                }
                nacc[v4] = acc;
            }
            if (wave == 0) {
                float d = 0.f;
#pragma unroll 2
                for (int q8 = 0; q8 < 16; ++q8) {
                    const u32x4 w = *(const u32x4*)(Pm + (lane * 136 + 8 * q8) * 2);
                    if (q8 < 8) d += (bflo(w.x) + bfhi(w.x)) + (bflo(w.y) + bfhi(w.y)) + (bflo(w.z) + bfhi(w.z)) + (bflo(w.w) + bfhi(w.w));
                    else { const float* np = nL + 8 * (q8 - 8);
                        d += bflo(w.x) * np[0] + bfhi(w.x) * np[1] + bflo(w.y) * np[2] + bfhi(w.y) * np[3] + bflo(w.z) * np[4] + bfhi(w.z) * np[5] + bflo(w.w) * np[6] + bfhi(w.w) * np[7]; }
                }
                denL[lane] = d;
                float ns = 0.f;
#pragma unroll 2
                for (int q8 = 0; q8 < 8; ++q8) {
                    const u32x4 w = *(const u32x4*)(KwT + (lane * 72 + 8 * q8) * 2);
                    ns += (bflo(w.x) + bfhi(w.x)) + (bflo(w.y) + bfhi(w.y)) + (bflo(w.z) + bfhi(w.z)) + (bflo(w.w) + bfhi(w.w));
                }
                nreg = sp * nreg + ns;
            }
#pragma unroll
            for (int kt = 0; kt < 4; ++kt) {
                f32x4 cc = Cacc[kt] * sp;
#pragma unroll
                for (int ks = 0; ks < 2; ++ks) {
                    const bf16x8 af = lds_b128(VsT + ((16 * wave + fr) * 72 + 32 * ks + 8 * fq) * 2);
                    const bf16x8 bfr = lds_b128(KwT + ((16 * kt + fr) * 72 + 32 * ks + 8 * fq) * 2);
                    cc = __builtin_amdgcn_mfma_f32_16x16x32_bf16(af, bfr, cc, 0, 0, 0);
                }
                Cacc[kt] = cc;
            }
            __syncthreads();
#pragma unroll
            for (int kt = 0; kt < 4; ++kt)
#pragma unroll
                for (int e = 0; e < 4; ++e) *(bf16_t*)(Cb + ((16 * wave + 4 * fq + e) * 72 + 16 * kt + fr) * 2) = (bf16_t)f2bf(Cacc[kt][e]);
            if (wave == 0) nL[lane] = nreg;
            const int irow = 16 * it + fr;
            const float dn = fmaxf(fabsf(denL[irow]), __expf(-mL[irow]));
            const float rdn = 1.0f / dn;
            float sq = 0.f;
#pragma unroll
            for (int v4 = 0; v4 < 4; ++v4) { nacc[v4] = nacc[v4] * rdn; sq += (nacc[v4][0] * nacc[v4][0] + nacc[v4][1] * nacc[v4][1]) + (nacc[v4][2] * nacc[v4][2] + nacc[v4][3] * nacc[v4][3]); }
            sq += __shfl_xor(sq, 16); sq += __shfl_xor(sq, 32);
            if (fq == 0) ssqL[irow * 2 + wh] = sq;
            __syncthreads();
            const float rn = 1.0f / sqrtf((ssqL[irow * 2] + ssqL[irow * 2 + 1]) * (1.f / 128.f) + RMS_EPS_F);
#pragma unroll
            for (int v4 = 0; v4 < 4; ++v4) {
                const int v = 16 * (4 * wh + v4) + 4 * fq;
                const u32x2 ow = *(const u32x2*)(P + (rowbase + irow) * PLD + 2048 + h * 128 + v);
                const f32x4 gn = *(const f32x4*)(gain + h * 128 + v);
                const float y0 = sigmoid_f(bflo(ow.x)) * nacc[v4][0] * rn * gn[0], y1 = sigmoid_f(bfhi(ow.x)) * nacc[v4][1] * rn * gn[1];
                const float y2 = sigmoid_f(bflo(ow.y)) * nacc[v4][2] * rn * gn[2], y3 = sigmoid_f(bfhi(ow.y)) * nacc[v4][3] * rn * gn[3];
                *(u32x2*)(Y + (rowbase + irow) * 1024 + h * 128 + v) = (u32x2){pk2(y0, y1), pk2(y2, y3)};
            }
            m_prev = mnew;
        }
    }
}

struct AttnUnit { int bl, g, h, dil, r, u0, hasprev; };
__device__ __forceinline__ AttnUnit attn_decode(int ui) {
    AttnUnit U; const int tile = ui & 31; U.h = (ui >> 5) & 7; const int rest = ui >> 8; U.g = rest % 3; U.bl = rest / 3;
    U.dil = (U.g == 0) ? 1 : (U.g == 1 ? 4 : 16);
    const int lpr = SEQ / U.dil, pos0 = 128 * tile; U.r = pos0 / lpr; U.u0 = pos0 % lpr; U.hasprev = (U.u0 > 0) ? 1 : 0;
    return U;
}
__device__ __forceinline__ s16x4 lds_tr(const unsigned char* p) {
    typedef short v4i16_t __attribute__((ext_vector_type(4)));
    return __builtin_bit_cast(s16x4, __builtin_amdgcn_ds_read_tr16_b64_v4i16((LASQ v4i16_t*)(p)));
}
__device__ __forceinline__ void attn_phase(const Args& a, unsigned char* lds, int tid, int lane, int wave) {
    bf16_t* QKV = (bf16_t*)(a.ws + OFF_R);
    float* lse = (float*)(a.ws + OFF_LSE);
    unsigned char* Kl = lds;
    unsigned char* Vl = lds + 34816;
    const int fr = lane & 15, fq = lane >> 4;
    const int NU = 8 * 3 * 8 * 32, GS = gridDim.x;
    int ui = blockIdx.x;
    if (ui >= NU) return;
    AttnUnit U = attn_decode(ui);
    int st = U.hasprev ? 0 : 1;
    u32x4 kreg[4], vreg[4];
    bf16x8 qnext[4], qf[4];
    auto load_stage = [&](const AttnUnit& X, int stg) {
        const int ub = X.u0 + (stg ? 0 : -128);
        const size_t cb = (size_t)X.g * 3072 + X.h * 128;
#pragma unroll
        for (int q = 0; q < 4; ++q) {
            const int cid = tid + 512 * q, key = cid >> 4, part = cid & 15;
            const size_t row = (size_t)X.bl * SEQ + (size_t)(ub + key) * X.dil + X.r;
            const bf16_t* p = QKV + row * 9216 + cb + part * 8;
            kreg[q] = *(const u32x4*)(p + 1024); vreg[q] = *(const u32x4*)(p + 2048);
        }
    };
    auto load_q = [&](const AttnUnit& X) {
        const size_t row = (size_t)X.bl * SEQ + (size_t)(X.u0 + 16 * wave + fr) * X.dil + X.r;
        const bf16_t* p = QKV + row * 9216 + (size_t)X.g * 3072 + X.h * 128 + 8 * fq;
#pragma unroll
        for (int ks = 0; ks < 4; ++ks) qnext[ks] = *(const bf16x8*)(p + 32 * ks);
    };
    load_stage(U, st); load_q(U);
    float mrow = -1e30f, lrow = 0.f;
    f32x4 oacc[8];
    bool first = true;
    for (;;) {
        AttnUnit Un = U; int stn; bool validn = true, firstn = false;
        if (st == 0) stn = 1;
        else { const int uin = ui + GS; if (uin < NU) { Un = attn_decode(uin); stn = Un.hasprev ? 0 : 1; firstn = true; } else { validn = false; stn = 1; } }
        __syncthreads();
#pragma unroll
        for (int q = 0; q < 4; ++q) {
            const int cid = tid + 512 * q, key = cid >> 4, part = cid & 15;
            *(u32x4*)(Kl + key * 272 + part * 16) = kreg[q];
            *(u32x4*)(Vl + key * 288 + part * 16) = vreg[q];
        }
        if (first) {
#pragma unroll
            for (int ks = 0; ks < 4; ++ks) qf[ks] = qnext[ks];
            mrow = -1e30f; lrow = 0.f;
#pragma unroll
            for (int vt = 0; vt < 8; ++vt) oacc[vt] = (f32x4){0.f, 0.f, 0.f, 0.f};
        }
        __syncthreads();
        if (validn) { load_stage(Un, stn); if (firstn) load_q(Un); }
        const int plo = (st == 0) ? (wave >> 1) : 0, phi = (st == 0) ? 3 : (wave >> 1);
        const int iq = 16 * wave + fr;
        for (int p = plo; p <= phi; ++p) {
            f32x4 s[2];
#pragma unroll
            for (int k2 = 0; k2 < 2; ++k2) {
                f32x4 acc = (f32x4){0.f, 0.f, 0.f, 0.f};
#pragma unroll
                for (int ks = 0; ks < 4; ++ks) {
                    const bf16x8 kf = *(const bf16x8*)(Kl + (32 * p + 16 * k2 + fr) * 272 + (32 * ks + 8 * fq) * 2);
                    acc = __builtin_amdgcn_mfma_f32_16x16x32_bf16(kf, qf[ks], acc, 0, 0, 0);
                }
                s[k2] = acc;
            }
            float mx = -1e30f;
#pragma unroll
            for (int k2 = 0; k2 < 2; ++k2)
#pragma unroll
                for (int e = 0; e < 4; ++e) {
                    const int j = 32 * p + 16 * k2 + 4 * fq + e;
                    const bool ok = (st == 0) ? (j >= iq) : (j <= iq);
                    s[k2][e] = ok ? s[k2][e] : -1e30f;
                    mx = fmaxf(mx, s[k2][e]);
                }
            mx = fmaxf(mx, __shfl_xor(mx, 16)); mx = fmaxf(mx, __shfl_xor(mx, 32));
            const float mnew = fmaxf(mrow, mx);
            const float alpha = __builtin_amdgcn_exp2f(mrow - mnew);
            float ps = 0.f; float pe[8];
#pragma unroll
            for (int k2 = 0; k2 < 2; ++k2)
#pragma unroll
                for (int e = 0; e < 4; ++e) { const float pv = __builtin_amdgcn_exp2f(s[k2][e] - mnew); pe[4 * k2 + e] = pv; ps += pv; }
            lrow = lrow * alpha + ps; mrow = mnew;
            const u32x4 pw = (u32x4){pk2(pe[0], pe[1]), pk2(pe[2], pe[3]), pk2(pe[4], pe[5]), pk2(pe[6], pe[7])};
            const bf16x8 pfrag = __builtin_bit_cast(bf16x8, pw);
            const unsigned char* vb0 = Vl + (32 * p + 4 * fq + (fr >> 2)) * 288 + (4 * (fr & 3)) * 2;
#pragma unroll
            for (int vt = 0; vt < 8; ++vt) {
                const s16x4 lo = lds_tr(vb0 + 32 * vt);
                const s16x4 hi = lds_tr(vb0 + 16 * 288 + 32 * vt);
                const bf16x8 vf = (bf16x8){lo[0], lo[1], lo[2], lo[3], hi[0], hi[1], hi[2], hi[3]};
                oacc[vt] = __builtin_amdgcn_mfma_f32_16x16x32_bf16(vf, pfrag, oacc[vt] * alpha, 0, 0, 0);
            }
        }
        if (st == 1) {
            float lt = lrow; lt += __shfl_xor(lt, 16); lt += __shfl_xor(lt, 32);
            const float inv = 1.0f / lt;
            const size_t row = (size_t)U.bl * SEQ + (size_t)(U.u0 + iq) * U.dil + U.r;
            bf16_t* op = QKV + row * 9216 + (size_t)U.g * 3072 + U.h * 128 + 4 * fq;
#pragma unroll
            for (int vt = 0; vt < 8; ++vt) { const f32x4 o = oacc[vt] * inv; *(u32x2*)(op + 16 * vt) = (u32x2){pk2(o[0], o[1]), pk2(o[2], o[3])}; }
            if (fq == 0) lse[((size_t)U.g * 32768 + row) * 8 + U.h] = (mrow + __builtin_amdgcn_logf(lt)) * 0.6931471805599453f;
        }
        if (!validn) break;
        if (st == 1) ui += GS;
        first = firstn; U = Un; st = stn;
    }
}
__device__ __forceinline__ void attn_merge_phase(const Args& a, int half, int lane, int wave) {
    const bf16_t* QKV = (const bf16_t*)(a.ws + OFF_R);
    const float* lse = (const float*)(a.ws + OFF_LSE);
    bf16_t* Y = (bf16_t*)(a.ws + OFF_Y) + (size_t)half * 32768 * 1024;
    const int gw = blockIdx.x * 8 + wave, NGW = gridDim.x * 8;
    const int hh = lane >> 3, d0 = (lane & 7) * 16;
    for (int rl = gw; rl < 32768; rl += NGW) {
        float ls[3], mx = -1e30f;
#pragma unroll
        for (int g = 0; g < 3; ++g) { ls[g] = lse[((size_t)g * 32768 + rl) * 8 + hh]; mx = fmaxf(mx, ls[g]); }
        float w[3], ws = 0.f;
#pragma unroll
        for (int g = 0; g < 3; ++g) { w[g] = __expf(ls[g] - mx); ws += w[g]; }
        const float iws = 1.0f / ws;
        float o[16];
#pragma unroll
        for (int e = 0; e < 16; ++e) o[e] = 0.f;
#pragma unroll
        for (int g = 0; g < 3; ++g) {
            const u32x4* p = (const u32x4*)(QKV + (size_t)rl * 9216 + g * 3072 + hh * 128 + d0);
            const u32x4 x0 = p[0], x1 = p[1]; const float wg = w[g] * iws;
            const unsigned xw[8] = {x0.x, x0.y, x0.z, x0.w, x1.x, x1.y, x1.z, x1.w};
#pragma unroll
            for (int e = 0; e < 8; ++e) { o[2 * e] += wg * bflo(xw[e]); o[2 * e + 1] += wg * bfhi(xw[e]); }
        }
        u32x4* yp = (u32x4*)(Y + (size_t)rl * 1024 + hh * 128 + d0);
        yp[0] = (u32x4){pk2(o[0], o[1]), pk2(o[2], o[3]), pk2(o[4], o[5]), pk2(o[6], o[7])};
        yp[1] = (u32x4){pk2(o[8], o[9]), pk2(o[10], o[11]), pk2(o[12], o[13]), pk2(o[14], o[15])};
    }
}

template <class Epi> __device__ __forceinline__ void run_gemm(unsigned char* lds, const bf16_t* A, const bf16_t* Bt, int M, int N, int K, const Epi& E) {
    pg8::Gemm g{A, Bt, M, N, K}; pg8::StaticOrder S; S.init(M, N, (int)gridDim.x, (int)blockIdx.x);
    pg8::gemm_phase<Epi, pg8::StaticOrder, true, true>((PG8_LAS unsigned char*)lds, g, S, E);
}
#ifndef RPT
#define RPT 0
#endif
#ifndef EN
#define EN 0xFFFF
#endif
enum { PT_P0 = 0, PT_LNMOD, PT_G1, PT_RES, PT_MPROJ, PT_MCELL, PT_QKV, PT_ATT, PT_MERGE, PT_FINAL };
constexpr int N_PHASES = 26;
__device__ __forceinline__ void phase_desc(int ph, int& type, int& l, int& s, int& x) {
    type = PT_P0; l = 0; s = 0; x = 0;
    switch (ph) {
        case 0: type = PT_P0; break;
        case 1: type = PT_LNMOD; l = 0; s = 0; break;
        case 2: type = PT_G1; l = 0; x = 0; break;
        case 3: type = PT_RES; l = 0; s = 0; break;
        case 4: type = PT_LNMOD; l = 0; s = 1; break;
        case 5: type = PT_MPROJ; break;
        case 6: type = PT_MCELL; break;
        case 7: type = PT_RES; l = 0; s = 1; break;
        case 8: type = PT_LNMOD; l = 0; s = 2; break;
        case 9: type = PT_G1; l = 0; x = 1; break;
        case 10: type = PT_RES; l = 0; s = 2; break;
        case 11: type = PT_LNMOD; l = 1; s = 0; break;
        case 12: type = PT_G1; l = 1; x = 0; break;
        case 13: type = PT_RES; l = 1; s = 0; break;
        case 14: type = PT_LNMOD; l = 1; s = 1; break;
        case 15: type = PT_QKV; x = 0; break;
        case 16: type = PT_ATT; x = 0; break;
        case 17: type = PT_MERGE; x = 0; break;
        case 18: type = PT_QKV; x = 1; break;
        case 19: type = PT_ATT; x = 1; break;
        case 20: type = PT_MERGE; x = 1; break;
        case 21: type = PT_RES; l = 1; s = 1; break;
        case 22: type = PT_LNMOD; l = 1; s = 2; break;
        case 23: type = PT_G1; l = 1; x = 1; break;
        case 24: type = PT_RES; l = 1; s = 2; break;
        default: type = PT_FINAL; break;
    }
}

__global__ void __launch_bounds__(512, 2) fwd_kernel(Args a_unused) {
#if defined(__HIP_DEVICE_COMPILE__)
    extern __shared__ __attribute__((aligned(16))) unsigned char lds[];
    cg::grid_group grid = cg::this_grid();
    typedef __attribute__((address_space(4))) const Args* KArgsPtr;
    KArgsPtr ap = (KArgsPtr)__builtin_amdgcn_kernarg_segment_ptr();
    const int ph_lo = ap->ph_lo;
    for (int ph = ph_lo; ; ++ph) {
        asm volatile("" : "+s"(ap));
        Args a;
#pragma unroll
        for (int i = 0; i < 15; ++i) a.in[i] = ap->in[i];
        a.out = ap->out; a.ws = ap->ws; a.ph_lo = ap->ph_lo; a.ph_hi = ap->ph_hi;
        int tid_l = threadIdx.x; asm volatile("" : "+v"(tid_l));
        const int tid = tid_l, lane = tid & 63, wave = __builtin_amdgcn_readfirstlane(tid >> 6);
        unsigned char* ws = a.ws;
        float* mod = (float*)(ws + OFF_MOD); float* stats = (float*)(ws + OFF_STATS);
        const float* x_in = a.in[0]; const float* lng = a.in[4]; const float* lnb = a.in[5];
        float* v = a.out;
        bf16_t* H = (bf16_t*)(ws + OFF_H); bf16_t* Yb = (bf16_t*)(ws + OFF_Y); bf16_t* R = (bf16_t*)(ws + OFF_R);
        if (ph >= a.ph_hi) break;
        int type, l, s, x;
#if RPT
        { int c = 0, bp = 0;
          for (; bp < N_PHASES; ++bp) { phase_desc(bp, type, l, s, x); const int n = ((RPT >> type) & 1) ? 2 : 1; if (ph < c + n) break; c += n; } }
#else
        phase_desc(ph, type, l, s, x);
#endif
        const int q = 3 * l + s;
        const int has_ln = (q > 0) ? 1 : 0;
        const float* pg = lng + (size_t)(q > 0 ? q - 1 : 0) * DM; const float* pb = lnb + (size_t)(q > 0 ? q - 1 : 0) * DM;
        const float* vin = (q > 0) ? (const float*)v : x_in;
        const float* modl = mod + (size_t)l * 16 * NMOD;
        if (type == PT_P0 && (EN >> PT_P0 & 1)) {
            p0_phase(a, lds, tid, lane, wave);
        } else if (type == PT_LNMOD && (EN >> PT_LNMOD & 1)) {
            lnmod_phase(vin, has_ln, pg, pb, modl, s, H, stats, lane, wave);
        } else if (type == PT_G1 && (EN >> PT_G1 & 1)) {
            EpiSwiGLU E{R};
            run_gemm(lds, H, (const bf16_t*)(ws + OFF_W1) + (size_t)(l * 2 + x) * 5632 * 1024, T, 5632, 1024, E);
        } else if (type == PT_RES && (EN >> PT_RES & 1)) {
            const bf16_t* A; const bf16_t* Bt; int K; float wgt;
            if (s == 1) { A = Yb; Bt = (const bf16_t*)(ws + (l == 0 ? OFF_WMO : OFF_WAO)); K = 1024; wgt = 1.0f; }
            else { A = R; Bt = (const bf16_t*)(ws + OFF_W2) + (size_t)(l * 2 + (s >> 1)) * 1024 * 2816; K = 2816; wgt = 0.5f; }
            EpiResidual E{vin, v, stats, pg, pb, modl + (s * 3 + 2) * DM, wgt, has_ln};
            run_gemm(lds, A, Bt, T, 1024, K, E);
        } else if (type == PT_MPROJ && (EN >> PT_MPROJ & 1)) {
            EpiStoreBf16 E{R, 3328};
            run_gemm(lds, H, (const bf16_t*)(ws + OFF_WM), T, 3328, 1024, E);
        } else if (type == PT_MCELL && (EN >> PT_MCELL & 1)) {
            mlstm_phase(a, lds, tid, lane, wave);
        } else if (type == PT_QKV && (EN >> PT_QKV & 1)) {
            EpiStoreBf16 E{R, 9216};
            run_gemm(lds, H + (size_t)x * 32768 * 1024, (const bf16_t*)(ws + OFF_WA), 32768, 9216, 1024, E);
        } else if (type == PT_ATT && (EN >> PT_ATT & 1)) {
            attn_phase(a, lds, tid, lane, wave);
        } else if (type == PT_MERGE && (EN >> PT_MERGE & 1)) {
            attn_merge_phase(a, x, lane, wave);
        } else {
            final_ln_phase(v, lng + 5 * DM, lnb + 5 * DM, lane, wave);
        }
        asm volatile("" : "+s"(ap));
        if (ph + 1 < ap->ph_hi) grid.sync();
    }
#endif
}

#ifndef MK_SPLIT
#define MK_SPLIT 0
#endif
extern "C" void kernel_launch(void* const* d_in, const int* in_sizes, int n_in, void* d_out, int out_size, void* d_ws, size_t ws_size, hipStream_t stream) {
    static int grid = 0;
    if (grid == 0) {
        if (n_in != 15 || out_size != T * DM || ws_size < WS_END) { fprintf(stderr, "kernel_launch: unexpected shapes (n_in %d out %d ws %zu)\n", n_in, out_size, ws_size); grid = -1; return; }
        int dev = 0, cus = 0, per_cu = 0;
        (void)hipGetDevice(&dev);
        (void)hipDeviceGetAttribute(&cus, hipDeviceAttributeMultiprocessorCount, dev);
        if (hipFuncSetAttribute((const void*)fwd_kernel, hipFuncAttributeMaxDynamicSharedMemorySize, LDS_BYTES) != hipSuccess) { fprintf(stderr, "kernel_launch: hipFuncSetAttribute failed\n"); grid = -1; return; }
        if (hipOccupancyMaxActiveBlocksPerMultiprocessor(&per_cu, (const void*)fwd_kernel, 512, LDS_BYTES) != hipSuccess || per_cu < 1) { fprintf(stderr, "kernel_launch: occupancy query says %d\n", per_cu); per_cu = 1; }
        (void)hipGetLastError();
        if (cus <= 0) cus = 256;
        grid = cus * 1;
    }
    if (grid < 0) return;
    Args a{};
    for (int i = 0; i < 15; ++i) a.in[i] = (const float*)d_in[i];
    a.out = (float*)d_out; a.ws = (unsigned char*)d_ws;
#if MK_SPLIT
    for (int ph = 0; ph < N_PHASES; ++ph) {
        a.ph_lo = ph; a.ph_hi = ph + 1;
        void* args[] = {&a};
        hipError_t e = hipLaunchCooperativeKernel((const void*)fwd_kernel, dim3(grid), dim3(512), args, LDS_BYTES, stream);
        if (e != hipSuccess) { fprintf(stderr, "kernel_launch: cooperative launch failed: %s\n", hipGetErrorString(e)); break; }
    }
#else
    a.ph_lo = 0; a.ph_hi = N_PHASES;
#if RPT
    { const int cnt[10] = {1, 6, 4, 6, 1, 1, 2, 2, 2, 1}; for (int t = 0; t < 10; ++t) if ((RPT >> t) & 1) a.ph_hi += cnt[t]; }
#endif
    void* args[] = {&a};
    hipError_t e = hipLaunchCooperativeKernel((const void*)fwd_kernel, dim3(grid), dim3(512), args, LDS_BYTES, stream);
    if (e != hipSuccess) fprintf(stderr, "kernel_launch: cooperative launch failed: %s (grid %d)\n", hipGetErrorString(e), grid);
#endif
}
```

```cpp
#include <hip/hip_runtime.h>
#include <hip/hip_cooperative_groups.h>
#include <cstdio>
#include <cstdint>
namespace cg = cooperative_groups;
namespace pg8 {
#define PG8_LAS __attribute__((address_space(3)))
typedef unsigned short bf16_t;
typedef short bf16x8 __attribute__((ext_vector_type(8)));
typedef float f32x4 __attribute__((ext_vector_type(4)));
typedef unsigned u32x4 __attribute__((ext_vector_type(4)));
constexpr int BM = 256, BK = 64, HALF = 128, HTB = HALF * BK * 2  , STAGE_BYTES = 8 * HTB, NXCD = 8, WGM = 8;

__host__ __device__ __forceinline__ int lds_byte(int r, int c) { const int st = (r >> 4) * 2 + (c >> 5), rr = r & 15, cc = c & 31, ob = rr * 64 + cc * 2; return st * 1024 + (ob ^ (((ob >> 9) & 1) << 5)); }
__host__ __device__ __forceinline__ void stage_rc(int b, int& R, int& C) { const int st = b / 1024, sb = b % 1024, swz = sb ^ (((sb >> 9) & 1) << 5); R = (st >> 1) * 16 + swz / 64; C = (st & 1) * 32 + (swz % 64) / 2; }
__host__ __device__ __forceinline__ int perm32(int rho) { const int n = rho >> 4, i = rho & 15; return 8 * (i >> 2) + 4 * n + (i & 3); }

struct Unit { int pm, pn; };
struct Gemm { const bf16_t* A; const bf16_t* Bt; int M, N, K; };

struct StaticOrder {
    int nM, nN, nwg, G, c;
    __host__ __device__ void init(int M, int N, int G_, int c_) { nM = M / BM; nN = N / BM; nwg = nM * nN; G = G_; c = c_; }
    __host__ __device__ bool next(int i, Unit& u) const {
        const long L = (long)i * G + c; if (L >= nwg) return false;
        int wgid = (int)L; { const int q = nwg / NXCD, r = nwg % NXCD, xcd = wgid % NXCD, off = wgid / NXCD; wgid = (xcd < r ? xcd * (q + 1) : r * (q + 1) + (xcd - r) * q) + off; }
        const int nig = WGM * nN, gid = wgid / nig, fm = gid * WGM, gsz = (nM - fm) < WGM ? (nM - fm) : WGM;
        u.pm = fm + ((wgid % nig) % gsz); u.pn = (wgid % nig) / gsz; return true;
    }
    __device__ __forceinline__ void a_ready(const Unit&) const {}
    __device__ __forceinline__ void done(const Unit&) const {}
};

__device__ __forceinline__ unsigned cvt_pk_bf16(float lo, float hi) { unsigned r; asm volatile("v_cvt_pk_bf16_f32 %0, %1, %2" : "=v"(r) : "v"(lo), "v"(hi)); return r; }
typedef float f32x2 __attribute__((ext_vector_type(2)));
template <class Epi, class Sched, bool ALIGN_EPI = false, bool SP2 = false>
__device__ __forceinline__ void gemm_phase(PG8_LAS unsigned char* lds, const Gemm g, const Sched& S, const Epi& E) {
    int tid_l = threadIdx.x; asm volatile("" : "+v"(tid_l)); const int tid = tid_l, wid = __builtin_amdgcn_readfirstlane(tid >> 6), lane = tid & 63, wr = wid >> 2, wc = wid & 3, fr = lane & 15, fq = lane >> 4;
    const int K = g.K, nt = K / BK;
    unsigned voffA[2], voffB[2];
#pragma unroll
    for (int i = 0; i < 2; ++i) { int R, C; stage_rc(tid * 16 + i * 8192, R, C); const int Rb = Epi::PERM ? ((R & ~31) + perm32(R & 31)) : R;
        voffA[i] = (unsigned)(R * K + C) * 2u; voffB[i] = (unsigned)(Rb * K + C) * 2u; }
    const size_t kstep = (size_t)(BK * 2);
    const size_t hstep = (size_t)HALF * K * 2;
    const size_t tstep = 2 * hstep;
    const unsigned ldsw = (unsigned)wid * 1024u;
    const int aoff = lds_byte(wr * 64 + fr, fq * 8), boff = lds_byte(wc * 32 + fr, fq * 8);
#define PG8_SA(b, h) (((b) * 2 + (h)) * HTB)
#define PG8_SB(b, h) ((4 + (b) * 2 + (h)) * HTB)
#define PG8_STAGE(bufoff, gbase, voff) do { _Pragma("unroll") for (int _i = 0; _i < 2; ++_i) \
        __builtin_amdgcn_global_load_lds((const unsigned*)((const char*)(gbase) + (voff)[_i]), (PG8_LAS unsigned*)(lds + (bufoff) + ldsw + _i * 8192), 16, 0, 0); } while (0)
#define PG8_LDA(dst, b, h) do { _Pragma("unroll") for (int m = 0; m < 4; ++m) _Pragma("unroll") for (int k = 0; k < 2; ++k) dst[m][k] = *(const PG8_LAS bf16x8*)(lds + PG8_SA(b, h) + aoff + m * 2048 + k * 1024); } while (0)
#define PG8_LDB(dst, b, h) do { _Pragma("unroll") for (int n = 0; n < 2; ++n) _Pragma("unroll") for (int k = 0; k < 2; ++k) dst[n][k] = *(const PG8_LAS bf16x8*)(lds + PG8_SB(b, h) + boff + n * 2048 + k * 1024); } while (0)
#define PG8_MMA(ai, bj, At, Bt) do { __builtin_amdgcn_s_setprio(1); _Pragma("unroll") for (int m = 0; m < 4; ++m) _Pragma("unroll") for (int n = 0; n < 2; ++n) _Pragma("unroll") for (int k = 0; k < 2; ++k) \
        acc[ai][bj][m][n] = __builtin_amdgcn_mfma_f32_16x16x32_bf16(Bt[n][k], At[m][k], acc[ai][bj][m][n], 0, 0, 0); __builtin_amdgcn_s_setprio(0); } while (0)
#define PG8_WAIT_V(n) asm volatile("s_waitcnt vmcnt(" #n ")" ::: "memory")
#define PG8_WAIT_L(n) asm volatile("s_waitcnt lgkmcnt(" #n ")" ::: "memory")
#define PG8_BAR __builtin_amdgcn_s_barrier()
#define PG8_SCHED __builtin_amdgcn_sched_barrier(0)
    Unit cur, nxt; int ui = 0;
    if (!S.next(0, cur)) return;
    f32x4 acc[2][2][4][2];
#pragma unroll
    for (int a = 0; a < 2; ++a)
#pragma unroll
        for (int b = 0; b < 2; ++b)
#pragma unroll
            for (int m = 0; m < 4; ++m)
#pragma unroll
                for (int n = 0; n < 2; ++n) acc[a][b][m][n] = (f32x4){0.f, 0.f, 0.f, 0.f};
    bf16x8 At[4][2], B0[2][2], B1[2][2];
    const char* cA = (const char*)g.A + (size_t)cur.pm * tstep; const char* cB = (const char*)g.Bt + (size_t)cur.pn * tstep;
    S.a_ready(cur);
    if constexpr (SP2) {
        PG8_STAGE(PG8_SB(0, 0), cB, voffB); PG8_STAGE(PG8_SB(0, 1), cB + hstep, voffB); PG8_STAGE(PG8_SA(0, 0), cA, voffA); PG8_STAGE(PG8_SA(0, 1), cA + hstep, voffA);
        if (wr == 1) PG8_BAR;
        PG8_WAIT_V(2); PG8_BAR;
        PG8_STAGE(PG8_SB(1, 0), cB + kstep, voffB); PG8_STAGE(PG8_SA(1, 0), cA + kstep, voffA); PG8_STAGE(PG8_SB(1, 1), cB + hstep + kstep, voffB);
        PG8_WAIT_V(6); PG8_BAR;
    } else {
        PG8_STAGE(PG8_SB(0, 0), cB, voffB); PG8_STAGE(PG8_SA(0, 0), cA, voffA); PG8_STAGE(PG8_SB(0, 1), cB + hstep, voffB); PG8_STAGE(PG8_SA(0, 1), cA + hstep, voffA);
        if (wr == 1) PG8_BAR;
        PG8_WAIT_V(4); PG8_BAR;
        PG8_STAGE(PG8_SB(1, 0), cB + kstep, voffB); PG8_STAGE(PG8_SA(1, 0), cA + kstep, voffA); PG8_STAGE(PG8_SB(1, 1), cB + hstep + kstep, voffB);
        PG8_WAIT_V(6); PG8_BAR;
    }
    for (;;) {
        const bool has_next = S.next(ui + 1, nxt);
        const char* nA = has_next ? (const char*)g.A + (size_t)nxt.pm * tstep : cA; const char* nB = has_next ? (const char*)g.Bt + (size_t)nxt.pn * tstep : cB;
        for (int t = 0; t < nt; t += 2) {
            const bool last = (t == nt - 2);
            const char* a1 = cA + (size_t)(t + 1) * kstep;
            const char* a2 = last ? nA : cA + (size_t)(t + 2) * kstep; const char* b2 = last ? nB : cB + (size_t)(t + 2) * kstep;
            const char* a3 = a2 + kstep; const char* b3 = b2 + kstep;
            if (last && has_next) S.a_ready(nxt);
            if constexpr (SP2) {
            PG8_LDB(B0, 0, 0); PG8_LDB(B1, 0, 1); PG8_SCHED; PG8_LDA(At, 0, 0); PG8_STAGE(PG8_SA(1, 1), a1 + hstep, voffA);
            PG8_WAIT_V(8); PG8_WAIT_L(0); PG8_BAR; PG8_MMA(0, 0, At, B0); PG8_MMA(0, 1, At, B1); PG8_BAR; PG8_SCHED;
            PG8_LDA(At, 0, 1); PG8_STAGE(PG8_SB(0, 0), b2, voffB); PG8_STAGE(PG8_SB(0, 1), b2 + hstep, voffB); PG8_STAGE(PG8_SA(0, 0), a2, voffA);
            PG8_WAIT_V(8); PG8_WAIT_L(0); PG8_BAR; PG8_MMA(1, 0, At, B0); PG8_MMA(1, 1, At, B1); PG8_BAR; PG8_SCHED;
            PG8_LDB(B0, 1, 0); PG8_LDB(B1, 1, 1); PG8_SCHED; PG8_LDA(At, 1, 0); PG8_STAGE(PG8_SA(0, 1), a2 + hstep, voffA);
            PG8_WAIT_V(8); PG8_WAIT_L(0); PG8_BAR; PG8_MMA(0, 0, At, B0); PG8_MMA(0, 1, At, B1); PG8_BAR; PG8_SCHED;
            PG8_LDA(At, 1, 1); PG8_STAGE(PG8_SB(1, 0), b3, voffB); PG8_STAGE(PG8_SB(1, 1), b3 + hstep, voffB); PG8_STAGE(PG8_SA(1, 0), a3, voffA);
            PG8_WAIT_V(8); PG8_WAIT_L(0); PG8_BAR; PG8_MMA(1, 0, At, B0); PG8_MMA(1, 1, At, B1); PG8_BAR; PG8_SCHED;
            } else {
            PG8_LDB(B0, 0, 0); PG8_SCHED; PG8_LDA(At, 0, 0); PG8_STAGE(PG8_SA(1, 1), a1 + hstep, voffA);
            PG8_WAIT_L(8); PG8_BAR; PG8_WAIT_L(0); PG8_MMA(0, 0, At, B0); PG8_BAR; PG8_SCHED;
            PG8_LDB(B1, 0, 1); PG8_STAGE(PG8_SB(0, 0), b2, voffB);
            PG8_BAR; PG8_WAIT_L(0); PG8_MMA(0, 1, At, B1); PG8_BAR;
            PG8_LDA(At, 0, 1); PG8_STAGE(PG8_SA(0, 0), a2, voffA);
            PG8_BAR; PG8_WAIT_L(0); PG8_MMA(1, 0, At, B0); PG8_BAR; PG8_SCHED;
            PG8_STAGE(PG8_SB(0, 1), b2 + hstep, voffB);
            PG8_WAIT_V(6); PG8_BAR; PG8_MMA(1, 1, At, B1); PG8_BAR;
            PG8_LDB(B0, 1, 0); PG8_SCHED; PG8_LDA(At, 1, 0); PG8_STAGE(PG8_SA(0, 1), a2 + hstep, voffA);
            PG8_WAIT_L(8); PG8_BAR; PG8_WAIT_L(0); PG8_MMA(0, 0, At, B0); PG8_BAR; PG8_SCHED;
            PG8_LDB(B1, 1, 1); PG8_STAGE(PG8_SB(1, 0), b3, voffB);
            PG8_BAR; PG8_WAIT_L(0); PG8_MMA(0, 1, At, B1); PG8_BAR;
            PG8_LDA(At, 1, 1); PG8_STAGE(PG8_SA(1, 0), a3, voffA);
            PG8_BAR; PG8_WAIT_L(0); PG8_MMA(1, 0, At, B0); PG8_BAR; PG8_SCHED;
            PG8_STAGE(PG8_SB(1, 1), b3 + hstep, voffB);
            PG8_WAIT_V(6); PG8_BAR; PG8_MMA(1, 1, At, B1); PG8_BAR;
            }
        }
        if constexpr (ALIGN_EPI) { if (wr == 0) PG8_BAR; }
        if constexpr (!Epi::AFTER_DRAIN) { E(acc, cur, wr, wc, fr, fq); S.done(cur); }
        if (!has_next) break;
#pragma unroll
        for (int a = 0; a < 2; ++a)
#pragma unroll
            for (int b = 0; b < 2; ++b)
#pragma unroll
                for (int m = 0; m < 4; ++m)
#pragma unroll
                    for (int n = 0; n < 2; ++n) acc[a][b][m][n] = (f32x4){0.f, 0.f, 0.f, 0.f};
        cur = nxt; cA = nA; cB = nB; ++ui;
        if constexpr (ALIGN_EPI) { if (wr == 1) PG8_BAR; }
    }
    PG8_WAIT_V(0);
    if constexpr (!ALIGN_EPI) { if (wr == 0) PG8_BAR; }
    PG8_BAR;
    if constexpr (Epi::AFTER_DRAIN) { E.fused(acc, cur, wr, wc, fr, fq, lds, wid, lane); S.done(cur); }
#undef PG8_SA
#undef PG8_SB
#undef PG8_STAGE
#undef PG8_LDA
#undef PG8_LDB
#undef PG8_MMA
#undef PG8_WAIT_V
#undef PG8_WAIT_L
#undef PG8_BAR
#undef PG8_SCHED
}
}

constexpr int NB = 16, SEQ = 4096, DM = 1024, DFF = 2816, T = NB * SEQ, NMOD = 9216;
constexpr float ALPHA_F = 1.41421356237309515f;
constexpr float LN_EPS_F = 1e-5f, RMS_EPS_F = 1e-6f;
constexpr size_t MiB = 1u << 20;
constexpr size_t OFF_MOD = 1 * MiB;
constexpr size_t OFF_STATS = 3 * MiB;
constexpr size_t OFF_LSE = 8 * MiB;
constexpr size_t OFF_W1 = 12 * MiB;
constexpr size_t OFF_W2 = 56 * MiB;
constexpr size_t OFF_WM = 78 * MiB;
constexpr size_t OFF_WMO = 85 * MiB;
constexpr size_t OFF_WA = 87 * MiB;
constexpr size_t OFF_WAO = 105 * MiB;
constexpr size_t OFF_H = 108 * MiB;
constexpr size_t OFF_Y = 236 * MiB;
constexpr size_t OFF_R = 364 * MiB;
constexpr size_t WS_END = 940 * MiB;
constexpr int LDS_BYTES = 155648;

typedef unsigned short bf16_t;
typedef short bf16x8 __attribute__((ext_vector_type(8)));
typedef float f32x4 __attribute__((ext_vector_type(4)));
typedef float f32x2 __attribute__((ext_vector_type(2)));
typedef unsigned u32x4 __attribute__((ext_vector_type(4)));
typedef unsigned u32x2 __attribute__((ext_vector_type(2)));
typedef short s16x4 __attribute__((ext_vector_type(4)));
#define LASQ __attribute__((address_space(3)))

__device__ __forceinline__ unsigned f2bf(float f) { unsigned u = __float_as_uint(f); return (u + 0x7fffu + ((u >> 16) & 1u)) >> 16; }
__device__ __forceinline__ unsigned pk2(float lo, float hi) { return pg8::cvt_pk_bf16(lo, hi); }
__device__ __forceinline__ float bf2f(unsigned short h) { return __uint_as_float(((unsigned)h) << 16); }
__device__ __forceinline__ float bflo(unsigned w) { return __uint_as_float(w << 16); }
__device__ __forceinline__ float bfhi(unsigned w) { return __uint_as_float(w & 0xffff0000u); }
__device__ __forceinline__ float wave_sum(float v) {
#pragma unroll
    for (int o = 1; o < 64; o <<= 1) v += __shfl_xor(v, o);
    return v;
}
__device__ __forceinline__ float wave_max(float v) {
#pragma unroll
    for (int o = 1; o < 64; o <<= 1) v = fmaxf(v, __shfl_xor(v, o));
    return v;
}
__device__ __forceinline__ float silu_f(float g) { return g * __builtin_amdgcn_rcpf(1.f + __expf(-g)); }
__device__ __forceinline__ float sigmoid_f(float g) { return __builtin_amdgcn_rcpf(1.f + __expf(-g)); }

struct Args { const float* in[15]; float* out; unsigned char* ws; int ph_lo, ph_hi; };
struct DArgs : Args { int bid, nbk; };

struct EpiSwiGLU {
    static constexpr bool PERM = true, AFTER_DRAIN = false;
    bf16_t* act;
    __device__ __forceinline__ void operator()(const f32x4 (&acc)[2][2][4][2], const pg8::Unit& u, int wr, int wc, int fr, int fq) const {
        const int row0 = u.pm * 256 + wr * 64 + fr, col0 = u.pn * 128 + wc * 32 + 8 * fq;
#pragma unroll
        for (int ai = 0; ai < 2; ++ai)
#pragma unroll
            for (int m = 0; m < 4; ++m) {
                bf16_t* p = act + (size_t)(row0 + ai * 128 + m * 16) * DFF + col0;
                const f32x4 g0 = acc[ai][0][m][0], g1 = acc[ai][0][m][1], u0 = acc[ai][1][m][0], u1 = acc[ai][1][m][1];
                u32x4 w;
                w.x = pk2(silu_f(g0[0]) * u0[0], silu_f(g0[1]) * u0[1]); w.y = pk2(silu_f(g0[2]) * u0[2], silu_f(g0[3]) * u0[3]);
                w.z = pk2(silu_f(g1[0]) * u1[0], silu_f(g1[1]) * u1[1]); w.w = pk2(silu_f(g1[2]) * u1[2], silu_f(g1[3]) * u1[3]);
                *(u32x4*)p = w;
            }
    }
};
struct EpiResidual {
    static constexpr bool PERM = false, AFTER_DRAIN = false;
    const float* vin; float* vout; const float* stats; const float* lng; const float* lnb; const float* gate; float wgt; int has_ln;
    __device__ __forceinline__ void operator()(const f32x4 (&acc)[2][2][4][2], const pg8::Unit& u, int wr, int wc, int fr, int fq) const {
        const int b = (u.pm * 256) >> 12;
        const int colb = u.pn * 256 + wc * 32 + 4 * fq;
        const float* gp = gate + (size_t)b * NMOD + colb;
#pragma unroll
        for (int bj = 0; bj < 2; ++bj)
#pragma unroll
            for (int n = 0; n < 2; ++n) {
                const int co = bj * 128 + n * 16;
                f32x4 gt = *(const f32x4*)(gp + co); gt = (gt + 1.0f) * wgt;
                f32x4 lg = (f32x4){ALPHA_F, ALPHA_F, ALPHA_F, ALPHA_F}, lb = (f32x4){0.f, 0.f, 0.f, 0.f};
                if (has_ln) { lg = *(const f32x4*)(lng + colb + co) * ALPHA_F; lb = *(const f32x4*)(lnb + colb + co) * ALPHA_F; }
#pragma unroll
                for (int ai = 0; ai < 2; ++ai)
#pragma unroll
                    for (int m = 0; m < 4; ++m) {
                        const int row = u.pm * 256 + ai * 128 + wr * 64 + m * 16 + fr;
                        const size_t off = (size_t)row * DM + colb + co;
                        f32x4 x = *(const f32x4*)(vin + off);
                        if (has_ln) { const f32x2 st = *(const f32x2*)(stats + 2 * (size_t)row); x = (x - st.x) * st.y; }
                        const f32x4 o = x * lg + lb + gt * acc[ai][bj][m][n];
                        *(f32x4*)(vout + off) = o;
                    }
            }
    }
};
struct EpiStoreBf16 {
    static constexpr bool PERM = true, AFTER_DRAIN = false;
    bf16_t* O; int ldc;
    __device__ __forceinline__ void operator()(const f32x4 (&acc)[2][2][4][2], const pg8::Unit& u, int wr, int wc, int fr, int fq) const {
        const int row0 = u.pm * 256 + wr * 64 + fr, col0 = u.pn * 256 + wc * 32 + 8 * fq;
#pragma unroll
        for (int ai = 0; ai < 2; ++ai)
#pragma unroll
            for (int m = 0; m < 4; ++m) {
                bf16_t* p = O + (size_t)(row0 + ai * 128 + m * 16) * ldc + col0;
#pragma unroll
                for (int bj = 0; bj < 2; ++bj) {
                    const f32x4 v0 = acc[ai][bj][m][0], v1 = acc[ai][bj][m][1];
                    u32x4 w; w.x = pk2(v0[0], v0[1]); w.y = pk2(v0[2], v0[3]); w.z = pk2(v1[0], v1[1]); w.w = pk2(v1[2], v1[3]);
                    *(u32x4*)(p + bj * 128) = w;
                }
            }
    }
};

__device__ __forceinline__ void transpose_item(const float* W, int K, int N, bf16_t* WT, int item, int nblk, bool perm_w1, bool qscale, float* scr, int lane) {
    const int kb = item / nblk, nb = item % nblk, k0 = 64 * kb, n0 = 32 * nb;
    const int ncol = n0 + (lane & 31);
#pragma unroll 8
    for (int i = 0; i < 32; ++i) { const int kk = 2 * i + (lane >> 5); scr[kk * 33 + (lane & 31)] = (ncol < N) ? W[(size_t)(k0 + kk) * N + ncol] : 0.f; }
    asm volatile("s_waitcnt lgkmcnt(0)" ::: "memory");
    int rbase = n0;
    if (perm_w1) rbase = (n0 < DFF) ? 256 * (n0 >> 7) + (n0 & 127) : 256 * ((n0 - DFF) >> 7) + 128 + ((n0 - DFF) & 127);
    const int c = lane & 7;
    const float sc = (qscale && (n0 % 3072) < 1024) ? 0.08838834764831845f * 1.4426950408889634f : 1.0f;
#pragma unroll
    for (int j = 0; j < 4; ++j) {
        const int n = (lane >> 3) + 8 * j; const float* s = scr + (8 * c) * 33 + n;
        u32x4 o; o.x = pk2(s[0 * 33] * sc, s[1 * 33] * sc); o.y = pk2(s[2 * 33] * sc, s[3 * 33] * sc); o.z = pk2(s[4 * 33] * sc, s[5 * 33] * sc); o.w = pk2(s[6 * 33] * sc, s[7 * 33] * sc);
        *(u32x4*)(WT + (size_t)(rbase + n) * K + k0 + 8 * c) = o;
    }
    asm volatile("s_waitcnt lgkmcnt(0)" ::: "memory");
}

__device__ __forceinline__ void p0_phase(const DArgs& a, unsigned char* lds, int tid, int lane, int wave) {
    float* sc = (float*)lds;
    float* red = (float*)(lds + 65536);
    const float* cin = a.in[1];
    for (int i = tid; i < 16 * 1024; i += 512) { const float v = cin[i]; sc[i] = silu_f(v); }
    __syncthreads();
    float* mod = (float*)(a.ws + OFF_MOD);
    for (int item = a.bid; item < 288; item += a.nbk) {
        const int l = item / 144, n0 = (item % 144) * 64;
        const float* W = a.in[2] + (size_t)l * 1024 * NMOD + n0 + lane;
        float acc[16];
#pragma unroll
        for (int b = 0; b < 16; ++b) acc[b] = 0.f;
        const int kb = wave * 128;
#pragma unroll 2
        for (int k = kb; k < kb + 128; k += 4) {
            const float w0 = W[(size_t)k * NMOD], w1 = W[(size_t)(k + 1) * NMOD], w2 = W[(size_t)(k + 2) * NMOD], w3 = W[(size_t)(k + 3) * NMOD];
#pragma unroll
            for (int b = 0; b < 16; ++b) { const f32x4 s = *(const f32x4*)(sc + b * 1024 + k); acc[b] += s[0] * w0 + s[1] * w1 + s[2] * w2 + s[3] * w3; }
        }
#pragma unroll
        for (int b = 0; b < 16; ++b) red[(wave * 16 + b) * 64 + lane] = acc[b];
        __syncthreads();
        for (int o = tid; o < 1024; o += 512) {
            const int b = o >> 6, n = o & 63; float s = 0.f;
#pragma unroll
            for (int w = 0; w < 8; ++w) s += red[(w * 16 + b) * 64 + n];
            mod[(size_t)(l * 16 + b) * NMOD + n0 + n] = s + a.in[3][l * NMOD + n0 + n];
        }
        __syncthreads();
    }
    float* scr = (float*)(lds + wave * 8448);
    const int gw = a.bid * 8 + wave, NGW = a.nbk * 8;
    constexpr int I_W1 = 16 * 176, I_W2 = 44 * 32, I_WM = 16 * 97, I_SQ = 16 * 32, I_WA = 16 * 288;
    constexpr int NITEMS = 4 * I_W1 + 4 * I_W2 + I_WM + I_SQ + I_WA + I_SQ;
    for (int it = gw; it < NITEMS; it += NGW) {
        int r = it;
        if (r < 4 * I_W1) { const int mi = r / I_W1; transpose_item(a.in[6] + (size_t)mi * 1024 * 5632, 1024, 5632, (bf16_t*)(a.ws + OFF_W1) + (size_t)mi * 5632 * 1024, r % I_W1, 176, true, false, scr, lane); continue; } r -= 4 * I_W1;
        if (r < 4 * I_W2) { const int mi = r / I_W2; transpose_item(a.in[7] + (size_t)mi * 2816 * 1024, 2816, 1024, (bf16_t*)(a.ws + OFF_W2) + (size_t)mi * 1024 * 2816, r % I_W2, 32, false, false, scr, lane); continue; } r -= 4 * I_W2;
        if (r < I_WM) { transpose_item(a.in[8], 1024, 3088, (bf16_t*)(a.ws + OFF_WM), r, 97, false, false, scr, lane); continue; } r -= I_WM;
        if (r < I_SQ) { transpose_item(a.in[12], 1024, 1024, (bf16_t*)(a.ws + OFF_WMO), r, 32, false, false, scr, lane); continue; } r -= I_SQ;
        if (r < I_WA) { transpose_item(a.in[13], 1024, 9216, (bf16_t*)(a.ws + OFF_WA), r, 288, false, true, scr, lane); continue; } r -= I_WA;
        transpose_item(a.in[14], 1024, 1024, (bf16_t*)(a.ws + OFF_WAO), r, 32, false, false, scr, lane);
    }
    for (int row = 3104 + gw; row < 3328; row += NGW) {
        u32x4* p = (u32x4*)((bf16_t*)(a.ws + OFF_WM) + (size_t)row * 1024);
        p[lane] = (u32x4){0u, 0u, 0u, 0u}; p[64 + lane] = (u32x4){0u, 0u, 0u, 0u};
    }
}

__device__ __forceinline__ void lnmod_phase(const float* vin, int has_ln, const float* lng, const float* lnb, const float* modl, int s,
                                            bf16_t* hout, float* stats, int lane, int wave, int bid, int nbk) {
    const int gw = bid * 8 + wave, NGW = nbk * 8;
    const int NG = T / 4, gpw = (NG + NGW - 1) / NGW;
    for (int gi = gw * gpw; gi < (gw + 1) * gpw && gi < NG; ++gi) {
        const int m0 = gi * 4, b = m0 >> 12;
        f32x4 v[4][4];
#pragma unroll
        for (int r = 0; r < 4; ++r) {
            const f32x4* xr = (const f32x4*)(vin + (size_t)(m0 + r) * DM) + lane;
#pragma unroll
            for (int j = 0; j < 4; ++j) v[r][j] = xr[64 * j];
        }
        const f32x4* shp = (const f32x4*)(modl + (size_t)b * NMOD + (s * 3 + 0) * DM) + lane;
        const f32x4* scp = (const f32x4*)(modl + (size_t)b * NMOD + (s * 3 + 1) * DM) + lane;
        f32x4 sc4[4], sh4[4];
#pragma unroll
        for (int j = 0; j < 4; ++j) { sc4[j] = scp[64 * j] + 1.0f; sh4[j] = shp[64 * j]; }
        if (has_ln) {
            f32x4 g4[4], b4[4];
#pragma unroll
            for (int j = 0; j < 4; ++j) { g4[j] = ((const f32x4*)lng)[lane + 64 * j]; b4[j] = ((const f32x4*)lnb)[lane + 64 * j]; }
#pragma unroll
            for (int j = 0; j < 4; ++j) { sh4[j] = b4[j] * sc4[j] + sh4[j]; sc4[j] = g4[j] * sc4[j]; }
#pragma unroll
            for (int r = 0; r < 4; ++r) {
                float sm = 0.f;
#pragma unroll
                for (int j = 0; j < 4; ++j) sm += (v[r][j][0] + v[r][j][1]) + (v[r][j][2] + v[r][j][3]);
                const float mean = wave_sum(sm) * (1.f / DM); float s2 = 0.f;
#pragma unroll
                for (int j = 0; j < 4; ++j) { v[r][j] = v[r][j] - mean; s2 += (v[r][j][0] * v[r][j][0] + v[r][j][1] * v[r][j][1]) + (v[r][j][2] * v[r][j][2] + v[r][j][3] * v[r][j][3]); }
                const float rstd = 1.f / sqrtf(wave_sum(s2) * (1.f / DM) + LN_EPS_F);
                if (lane == 0) *(f32x2*)(stats + 2 * (size_t)(m0 + r)) = (f32x2){mean, rstd};
#pragma unroll
                for (int j = 0; j < 4; ++j) v[r][j] = v[r][j] * rstd;
            }
        }
#pragma unroll
        for (int r = 0; r < 4; ++r) {
            u32x2* o8 = (u32x2*)(hout + (size_t)(m0 + r) * DM) + lane;
#pragma unroll
            for (int j = 0; j < 4; ++j) {
                const f32x4 h = v[r][j] * sc4[j] + sh4[j];
                o8[64 * j] = (u32x2){pk2(h[0], h[1]), pk2(h[2], h[3])};
            }
        }
    }
}
__device__ __forceinline__ void final_ln_phase(float* v_io, const float* lng, const float* lnb, int lane, int wave, int bid, int nbk) {
    const int gw = bid * 8 + wave, NGW = nbk * 8;
    const int NG = T / 4, gpw = (NG + NGW - 1) / NGW;
    for (int gi = gw * gpw; gi < (gw + 1) * gpw && gi < NG; ++gi) {
        const int m0 = gi * 4;
        f32x4 v[4][4];
#pragma unroll
        for (int r = 0; r < 4; ++r) {
            const f32x4* xr = (const f32x4*)(v_io + (size_t)(m0 + r) * DM) + lane;
#pragma unroll
            for (int j = 0; j < 4; ++j) v[r][j] = xr[64 * j];
        }
        f32x4 g4[4], b4[4];
#pragma unroll
        for (int j = 0; j < 4; ++j) { g4[j] = ((const f32x4*)lng)[lane + 64 * j]; b4[j] = ((const f32x4*)lnb)[lane + 64 * j]; }
#pragma unroll
        for (int r = 0; r < 4; ++r) {
            float sm = 0.f;
#pragma unroll
            for (int j = 0; j < 4; ++j) sm += (v[r][j][0] + v[r][j][1]) + (v[r][j][2] + v[r][j][3]);
            const float mean = wave_sum(sm) * (1.f / DM); float s2 = 0.f;
#pragma unroll
            for (int j = 0; j < 4; ++j) { v[r][j] = v[r][j] - mean; s2 += (v[r][j][0] * v[r][j][0] + v[r][j][1] * v[r][j][1]) + (v[r][j][2] * v[r][j][2] + v[r][j][3] * v[r][j][3]); }
            const float rstd = 1.f / sqrtf(wave_sum(s2) * (1.f / DM) + LN_EPS_F);
            f32x4* xo = (f32x4*)(v_io + (size_t)(m0 + r) * DM) + lane;
#pragma unroll
            for (int j = 0; j < 4; ++j) xo[64 * j] = v[r][j] * rstd * g4[j] + b4[j];
        }
    }
}

__device__ __forceinline__ bf16x8 lds_b128(const unsigned char* p) { return *(const bf16x8*)p; }
__device__ __forceinline__ void mlstm_phase(const DArgs& a, unsigned char* lds, int tid, int lane, int wave) {
    const bf16_t* P = (const bf16_t*)(a.ws + OFF_R);
    constexpr int PLD = 3328;
    bf16_t* Y = (bf16_t*)(a.ws + OFF_Y);
    const float* gbias = a.in[9]; const float* convw = a.in[10]; const float* gain = a.in[11];
    unsigned char* Qs = lds;
    unsigned char* Ks = lds + 9216;
    unsigned char* KwT = lds + 18432;
    unsigned char* VsT = lds + 27648;
    unsigned char* Cb = lds + 46080;
    unsigned char* Pm = lds + 64512;
    unsigned char* rawT = lds + 81920;
    unsigned char* halo = lds + 98304;
    float* bcA = (float*)(lds + 99328);
    float* cTA = bcA + 4096;
    float* pmA = cTA + 4096;
    float* fl = pmA + 4096;
    float* rowT = fl;
    float* mL = fl + 64;
    float* nL = fl + 128;
    float* denL = fl + 192;
    float* ssqL = fl + 256;
    const int fr = lane & 15, fq = lane >> 4;
    const int it = wave >> 1, wh = wave & 1;
    for (int unit = a.bid; unit < 128; unit += a.nbk) {
        const int b = unit >> 3, h = unit & 7;
        const bf16_t* pu = P + (size_t)b * SEQ * PLD;
        f32x4 Cacc[4];
#pragma unroll
        for (int kt = 0; kt < 4; ++kt) Cacc[kt] = (f32x4){0.f, 0.f, 0.f, 0.f};
        float m_prev = 0.f;
        const int isk = wave & 1, kk = lane, tq = wave >> 1;
        const int gcol = isk * 512 + h * 64 + kk;
        const float cw0 = convw[gcol], cw1 = convw[1024 + gcol], cw2 = convw[2048 + gcol], cw3 = convw[3072 + gcol];
        const int rrow = tid >> 3, rch = tid & 7;
        const unsigned raw_off = (unsigned)rrow * PLD + (unsigned)(h * 64 + 8 * rch);
        const unsigned v_off = (unsigned)lane * PLD + (unsigned)(1024 + h * 128 + 16 * wave);
        const int irow = 16 * it + fr;
        const unsigned o_off = (unsigned)irow * PLD + (unsigned)(2048 + h * 128 + 64 * wh + 4 * fq);
        u32x4 rawreg[2], vreg[2]; u32x2 oreg[4];
        auto load_raw = [&](int c) { const bf16_t* p = pu + (size_t)c * 64 * PLD + raw_off; rawreg[0] = *(const u32x4*)p; rawreg[1] = *(const u32x4*)(p + 512); };
        auto load_v = [&](int c) { const bf16_t* p = pu + (size_t)c * 64 * PLD + v_off; vreg[0] = *(const u32x4*)p; vreg[1] = *(const u32x4*)(p + 8); };
        auto load_o = [&](int c) { const bf16_t* p = pu + (size_t)c * 64 * PLD + o_off;
#pragma unroll
            for (int v4 = 0; v4 < 4; ++v4) oreg[v4] = *(const u32x2*)(p + 16 * v4); };
        auto store_v = [&](int wave, int lane) {
            const unsigned vw[8] = {vreg[0].x, vreg[0].y, vreg[0].z, vreg[0].w, vreg[1].x, vreg[1].y, vreg[1].z, vreg[1].w};
#pragma unroll
            for (int e = 0; e < 8; ++e) {
                *(bf16_t*)(VsT + ((16 * wave + 2 * e) * 72 + lane) * 2) = (bf16_t)(vw[e] & 0xffffu);
                *(bf16_t*)(VsT + ((16 * wave + 2 * e + 1) * 72 + lane) * 2) = (bf16_t)(vw[e] >> 16);
            } };
        load_raw(0); load_v(0); load_o(0);
        __syncthreads();
        {
            const float gb_i = gbias[h], gb_f = gbias[8 + h];
#pragma unroll 1
            for (int q = 0; q < 8; ++q) {
                const bf16_t* p = pu + (size_t)((wave + 8 * q) * 64 + lane) * PLD + 3072 + h;
                const float gi = bf2f(p[0]) + gb_i, fp = bf2f(p[8]) + gb_f;
                const float lf = fminf(fp, 0.f) - log1pf(__expf(-fabsf(fp)));
                float bc = lf;
#pragma unroll
                for (int o = 1; o < 64; o <<= 1) { const float t = __shfl_up(bc, o); if (lane >= o) bc += t; }
                const float ct = gi - bc;
                float pmx = ct;
#pragma unroll
                for (int o = 1; o < 64; o <<= 1) { const float t = __shfl_up(pmx, o); if (lane >= o) pmx = fmaxf(pmx, t); }
                const int idx = (wave + 8 * q) * 64 + lane;
                bcA[idx] = bc; cTA[idx] = ct; pmA[idx] = pmx;
            }
        }
        *(u32x4*)(rawT + rrow * 256 + rch * 16) = rawreg[0]; *(u32x4*)(rawT + rrow * 256 + 128 + rch * 16) = rawreg[1];
        if (tid < 48) *(u32x4*)(halo + tid * 16) = (u32x4){0u, 0u, 0u, 0u};
        store_v(wave, lane);
        for (int i = tid; i < 128 * 72 / 2; i += 512) ((unsigned*)Cb)[i] = 0u;
        if (tid < 64) nL[tid] = 0.f;
        load_raw(1); load_v(1);
        __syncthreads();
        const int tid_o = tid;
        for (int c = 0; c < 64; ++c) {
            const int t0 = c * 64; const size_t rowbase = (size_t)b * SEQ + t0;
            int tid_c = tid_o; asm volatile("" : "+v"(tid_c));
            const int tid = tid_c, lane = tid & 63, wave = __builtin_amdgcn_readfirstlane(tid >> 6);
            const int fr = lane & 15, fq = lane >> 4, it = wave >> 1, wh = wave & 1;
            const int isk = wave & 1, kk = lane, tq = wave >> 1, rrow = tid >> 3, rch = tid & 7, irow = 16 * it + fr;
            const float bc = bcA[t0 + lane], ct = cTA[t0 + lane], pmx = pmA[t0 + lane];
            const float blast = bcA[t0 + 63];
            const float mloc = blast + pmA[t0 + 63];
            const float mnew = fmaxf(blast + m_prev, mloc);
            const float sp = __expf(blast + m_prev - mnew);
            const float wa = __expf(blast + ct - mnew);
            const float mi = fmaxf(bc + m_prev, bc + pmx);
            const float iw = __expf(bc + m_prev - mi);
            if (wave == 0) { rowT[lane] = bc - mi; mL[lane] = mi; }
            {
                float x[19];
                const int cch = isk * 64 + kk;
#pragma unroll
                for (int e = 0; e < 19; ++e) {
                    const int rr = 16 * tq - 3 + e;
                    const bf16_t hv = (e < 3) ? ((tq == 0) ? *(const bf16_t*)(halo + (e * 128 + cch) * 2) : *(const bf16_t*)(rawT + ((16 * tq - 3 + e) * 128 + cch) * 2))
                                              : *(const bf16_t*)(rawT + (rr * 128 + cch) * 2);
                    x[e] = bf2f(hv);
                }
#pragma unroll
                for (int e = 0; e < 16; ++e) {
                    const int j = 16 * tq + e;
                    float y = cw0 * x[e] + cw1 * x[e + 1] + cw2 * x[e + 2] + cw3 * x[e + 3];
                    y = silu_f(y);
                    if (!isk) {
                        const float qs = y * 0.125f; const float iwj = __shfl(iw, j);
                        *(bf16_t*)(Qs + (j * 72 + kk) * 2) = (bf16_t)f2bf(qs);
                        *(bf16_t*)(Pm + (j * 136 + 64 + kk) * 2) = (bf16_t)f2bf(iwj * qs);
                    } else {
                        const float waj = __shfl(wa, j);
                        *(bf16_t*)(Ks + (j * 72 + kk) * 2) = (bf16_t)f2bf(y);
                        *(bf16_t*)(KwT + (kk * 72 + j) * 2) = (bf16_t)f2bf(waj * y);
                    }
                }
            }
            __syncthreads();
            {
                unsigned char* d0 = rawT + rrow * 256 + rch * 16;
                if (rrow >= 61) { *(u32x4*)(halo + (rrow - 61) * 256 + rch * 16) = *(const u32x4*)d0; *(u32x4*)(halo + (rrow - 61) * 256 + 128 + rch * 16) = *(const u32x4*)(d0 + 128); }
                *(u32x4*)d0 = rawreg[0]; *(u32x4*)(d0 + 128) = rawreg[1];
                load_raw(c + 2 < 64 ? c + 2 : 63);
            }
#pragma unroll
            for (int jj2 = 0; jj2 < 2; ++jj2) {
                const int jt = 2 * wh + jj2;
                f32x4 s = (f32x4){0.f, 0.f, 0.f, 0.f};
#pragma unroll
                for (int ks = 0; ks < 2; ++ks) {
                    const bf16x8 kf = lds_b128(Ks + ((16 * jt + fr) * 72 + 32 * ks + 8 * fq) * 2);
                    const bf16x8 qf = lds_b128(Qs + ((16 * it + fr) * 72 + 32 * ks + 8 * fq) * 2);
                    s = __builtin_amdgcn_mfma_f32_16x16x32_bf16(kf, qf, s, 0, 0, 0);
                }
                const int i = irow; const float rt = rowT[i];
                const f32x4 c4 = *(const f32x4*)(cTA + t0 + 16 * jt + 4 * fq);
                float p[4];
#pragma unroll
                for (int e = 0; e < 4; ++e) { const int j = 16 * jt + 4 * fq + e; p[e] = (j <= i) ? s[e] * __expf(rt + c4[e]) : 0.f; }
                *(u32x2*)(Pm + (i * 136 + 16 * jt + 4 * fq) * 2) = (u32x2){pk2(p[0], p[1]), pk2(p[2], p[3])};
            }
            __syncthreads();
            f32x4 nacc[4];
#pragma unroll
            for (int v4 = 0; v4 < 4; ++v4) {
                const int vt = 4 * wh + v4; f32x4 acc = (f32x4){0.f, 0.f, 0.f, 0.f};
#pragma unroll
                for (int ks = 0; ks < 4; ++ks) {
                    const bf16x8 af = (ks < 2) ? lds_b128(VsT + ((16 * vt + fr) * 72 + 32 * ks + 8 * fq) * 2)
                                               : lds_b128(Cb + ((16 * vt + fr) * 72 + 32 * (ks - 2) + 8 * fq) * 2);
                    const bf16x8 bfr = lds_b128(Pm + ((16 * it + fr) * 136 + 32 * ks + 8 * fq) * 2);
                    acc = __builtin_amdgcn_mfma_f32_16x16x32_bf16(af, bfr, acc, 0, 0, 0);
                }
                nacc[v4] = acc;
            }
            float nsum;
            {
                const int di = tid >> 3, dp = tid & 7;
                const u32x4 w0 = *(const u32x4*)(Pm + (di * 136 + 16 * dp) * 2), w1 = *(const u32x4*)(Pm + (di * 136 + 16 * dp + 8) * 2);
                const unsigned ww[8] = {w0.x, w0.y, w0.z, w0.w, w1.x, w1.y, w1.z, w1.w};
                float d = 0.f;
                if (dp < 4) {
#pragma unroll
                    for (int e = 0; e < 8; ++e) d += bflo(ww[e]) + bfhi(ww[e]);
                } else {
                    const float* np = nL + 16 * (dp - 4);
#pragma unroll
                    for (int e = 0; e < 8; ++e) d += bflo(ww[e]) * np[2 * e] + bfhi(ww[e]) * np[2 * e + 1];
                }
                d += __shfl_xor(d, 1); d += __shfl_xor(d, 2); d += __shfl_xor(d, 4);
                if (dp == 0) denL[di] = d;
                const u32x4 kw = *(const u32x4*)(KwT + (di * 72 + 8 * dp) * 2);
                float ns = (bflo(kw.x) + bfhi(kw.x)) + (bflo(kw.y) + bfhi(kw.y)) + (bflo(kw.z) + bfhi(kw.z)) + (bflo(kw.w) + bfhi(kw.w));
                ns += __shfl_xor(ns, 1); ns += __shfl_xor(ns, 2); ns += __shfl_xor(ns, 4);
                nsum = ns;
            }
#pragma unroll
            for (int kt = 0; kt < 4; ++kt) {
                f32x4 cc = Cacc[kt] * sp;
#pragma unroll
                for (int ks = 0; ks < 2; ++ks) {
                    const bf16x8 af = lds_b128(VsT + ((16 * wave + fr) * 72 + 32 * ks + 8 * fq) * 2);
                    const bf16x8 bfr = lds_b128(KwT + ((16 * kt + fr) * 72 + 32 * ks + 8 * fq) * 2);
                    cc = __builtin_amdgcn_mfma_f32_16x16x32_bf16(af, bfr, cc, 0, 0, 0);
                }
                Cacc[kt] = cc;
            }
            __syncthreads();
#pragma unroll
            for (int kt = 0; kt < 4; ++kt)
#pragma unroll
                for (int e = 0; e < 4; ++e) *(bf16_t*)(Cb + ((16 * wave + 4 * fq + e) * 72 + 16 * kt + fr) * 2) = (bf16_t)f2bf(Cacc[kt][e]);
            if ((tid & 7) == 0) nL[tid >> 3] = sp * nL[tid >> 3] + nsum;
            store_v(wave, lane); load_v(c + 2 < 64 ? c + 2 : 63);
            const float dn = fmaxf(fabsf(denL[irow]), __expf(-mL[irow]));
            const float rdn = 1.0f / dn;
            float sq = 0.f;
#pragma unroll
            for (int v4 = 0; v4 < 4; ++v4) { nacc[v4] = nacc[v4] * rdn; sq += (nacc[v4][0] * nacc[v4][0] + nacc[v4][1] * nacc[v4][1]) + (nacc[v4][2] * nacc[v4][2] + nacc[v4][3] * nacc[v4][3]); }
            sq += __shfl_xor(sq, 16); sq += __shfl_xor(sq, 32);
            if (fq == 0) ssqL[irow * 2 + wh] = sq;
            __syncthreads();
            const float rn = 1.0f / sqrtf((ssqL[irow * 2] + ssqL[irow * 2 + 1]) * (1.f / 128.f) + RMS_EPS_F);
#pragma unroll
            for (int v4 = 0; v4 < 4; ++v4) {
                const int v = 16 * (4 * wh + v4) + 4 * fq;
                const u32x2 ow = oreg[v4];
                const f32x4 gn = *(const f32x4*)(gain + h * 128 + v);
                const float y0 = sigmoid_f(bflo(ow.x)) * nacc[v4][0] * rn * gn[0], y1 = sigmoid_f(bfhi(ow.x)) * nacc[v4][1] * rn * gn[1];
                const float y2 = sigmoid_f(bflo(ow.y)) * nacc[v4][2] * rn * gn[2], y3 = sigmoid_f(bfhi(ow.y)) * nacc[v4][3] * rn * gn[3];
                *(u32x2*)(Y + (rowbase + irow) * 1024 + h * 128 + v) = (u32x2){pk2(y0, y1), pk2(y2, y3)};
            }
            load_o(c + 1 < 64 ? c + 1 : 63);
            m_prev = mnew;
        }
    }
}

struct AttnUnit { int bl, g, h, dil, r, u0, hasprev; };
__device__ __forceinline__ AttnUnit attn_decode(int ui) {
    AttnUnit U; const int tile = ui & 31; U.h = (ui >> 5) & 7; const int rest = ui >> 8; U.g = rest % 3; U.bl = rest / 3;
    U.dil = (U.g == 0) ? 1 : (U.g == 1 ? 4 : 16);
    const int lpr = SEQ / U.dil, pos0 = 128 * tile; U.r = pos0 / lpr; U.u0 = pos0 % lpr; U.hasprev = (U.u0 > 0) ? 1 : 0;
    return U;
}
__device__ __forceinline__ s16x4 lds_tr(const unsigned char* p) {
    typedef short v4i16_t __attribute__((ext_vector_type(4)));
    return __builtin_bit_cast(s16x4, __builtin_amdgcn_ds_read_tr16_b64_v4i16((LASQ v4i16_t*)(p)));
}
__device__ __forceinline__ void attn_phase(const DArgs& a, unsigned char* lds, int tid, int lane, int wave) {
    bf16_t* QKV = (bf16_t*)(a.ws + OFF_R);
    float* lse = (float*)(a.ws + OFF_LSE);
    unsigned char* Kl = lds;
    unsigned char* Vl = lds + 34816;
    const int fr = lane & 15, fq = lane >> 4;
    const int NU = 8 * 3 * 8 * 32, GS = a.nbk;
    int ui = a.bid;
    if (ui >= NU) return;
    AttnUnit U = attn_decode(ui);
    int st = U.hasprev ? 0 : 1;
    u32x4 kreg[4], vreg[4];
    bf16x8 qnext[4], qf[4];
    auto load_stage = [&](const AttnUnit& X, int stg) {
        const int ub = X.u0 + (stg ? 0 : -128);
        const size_t cb = (size_t)X.g * 3072 + X.h * 128;
#pragma unroll
        for (int q = 0; q < 4; ++q) {
            const int cid = tid + 512 * q, key = cid >> 4, part = cid & 15;
            const size_t row = (size_t)X.bl * SEQ + (size_t)(ub + key) * X.dil + X.r;
            const bf16_t* p = QKV + row * 9216 + cb + part * 8;
            kreg[q] = *(const u32x4*)(p + 1024); vreg[q] = *(const u32x4*)(p + 2048);
        }
    };
    auto load_q = [&](const AttnUnit& X) {
        const size_t row = (size_t)X.bl * SEQ + (size_t)(X.u0 + 16 * wave + fr) * X.dil + X.r;
        const bf16_t* p = QKV + row * 9216 + (size_t)X.g * 3072 + X.h * 128 + 8 * fq;
#pragma unroll
        for (int ks = 0; ks < 4; ++ks) qnext[ks] = *(const bf16x8*)(p + 32 * ks);
    };
    load_stage(U, st); load_q(U);
    float mrow = -1e30f, lrow = 0.f;
    f32x4 oacc[8];
    bool first = true;
    for (;;) {
        AttnUnit Un = U; int stn; bool validn = true, firstn = false;
        if (st == 0) stn = 1;
        else { const int uin = ui + GS; if (uin < NU) { Un = attn_decode(uin); stn = Un.hasprev ? 0 : 1; firstn = true; } else { validn = false; stn = 1; } }
        __syncthreads();
#pragma unroll
        for (int q = 0; q < 4; ++q) {
            const int cid = tid + 512 * q, key = cid >> 4, part = cid & 15;
            *(u32x4*)(Kl + key * 272 + part * 16) = kreg[q];
            *(u32x4*)(Vl + key * 288 + part * 16) = vreg[q];
        }
        if (first) {
#pragma unroll
            for (int ks = 0; ks < 4; ++ks) qf[ks] = qnext[ks];
            mrow = -1e30f; lrow = 0.f;
#pragma unroll
            for (int vt = 0; vt < 8; ++vt) oacc[vt] = (f32x4){0.f, 0.f, 0.f, 0.f};
        }
        __syncthreads();
        if (validn) { load_stage(Un, stn); if (firstn) load_q(Un); }
        const int plo = (st == 0) ? (wave >> 1) : 0, phi = (st == 0) ? 3 : (wave >> 1);
        const int iq = 16 * wave + fr;
        for (int p = plo; p <= phi; ++p) {
            f32x4 s[2];
#pragma unroll
            for (int k2 = 0; k2 < 2; ++k2) {
                f32x4 acc = (f32x4){0.f, 0.f, 0.f, 0.f};
#pragma unroll
                for (int ks = 0; ks < 4; ++ks) {
                    const bf16x8 kf = *(const bf16x8*)(Kl + (32 * p + 16 * k2 + fr) * 272 + (32 * ks + 8 * fq) * 2);
                    acc = __builtin_amdgcn_mfma_f32_16x16x32_bf16(kf, qf[ks], acc, 0, 0, 0);
                }
                s[k2] = acc;
            }
            float mx = -1e30f;
#pragma unroll
            for (int k2 = 0; k2 < 2; ++k2)
#pragma unroll
                for (int e = 0; e < 4; ++e) {
                    const int j = 32 * p + 16 * k2 + 4 * fq + e;
                    const bool ok = (st == 0) ? (j >= iq) : (j <= iq);
                    s[k2][e] = ok ? s[k2][e] : -1e30f;
                    mx = fmaxf(mx, s[k2][e]);
                }
            mx = fmaxf(mx, __shfl_xor(mx, 16)); mx = fmaxf(mx, __shfl_xor(mx, 32));
            const float mnew = fmaxf(mrow, mx);
            const float alpha = __builtin_amdgcn_exp2f(mrow - mnew);
            float ps = 0.f; float pe[8];
#pragma unroll
            for (int k2 = 0; k2 < 2; ++k2)
#pragma unroll
                for (int e = 0; e < 4; ++e) { const float pv = __builtin_amdgcn_exp2f(s[k2][e] - mnew); pe[4 * k2 + e] = pv; ps += pv; }
            lrow = lrow * alpha + ps; mrow = mnew;
            const u32x4 pw = (u32x4){pk2(pe[0], pe[1]), pk2(pe[2], pe[3]), pk2(pe[4], pe[5]), pk2(pe[6], pe[7])};
            const bf16x8 pfrag = __builtin_bit_cast(bf16x8, pw);
            const unsigned char* vb0 = Vl + (32 * p + 4 * fq + (fr >> 2)) * 288 + (4 * (fr & 3)) * 2;
#pragma unroll
            for (int vt = 0; vt < 8; ++vt) {
                const s16x4 lo = lds_tr(vb0 + 32 * vt);
                const s16x4 hi = lds_tr(vb0 + 16 * 288 + 32 * vt);
                const bf16x8 vf = (bf16x8){lo[0], lo[1], lo[2], lo[3], hi[0], hi[1], hi[2], hi[3]};
                oacc[vt] = __builtin_amdgcn_mfma_f32_16x16x32_bf16(vf, pfrag, oacc[vt] * alpha, 0, 0, 0);
            }
        }
        if (st == 1) {
            float lt = lrow; lt += __shfl_xor(lt, 16); lt += __shfl_xor(lt, 32);
            const float inv = 1.0f / lt;
            const size_t row = (size_t)U.bl * SEQ + (size_t)(U.u0 + iq) * U.dil + U.r;
            bf16_t* op = QKV + row * 9216 + (size_t)U.g * 3072 + U.h * 128 + 4 * fq;
#pragma unroll
            for (int vt = 0; vt < 8; ++vt) { const f32x4 o = oacc[vt] * inv; *(u32x2*)(op + 16 * vt) = (u32x2){pk2(o[0], o[1]), pk2(o[2], o[3])}; }
            if (fq == 0) lse[((size_t)U.g * 32768 + row) * 8 + U.h] = (mrow + __builtin_amdgcn_logf(lt)) * 0.6931471805599453f;
        }
        if (!validn) break;
        if (st == 1) ui += GS;
        first = firstn; U = Un; st = stn;
    }
}
__device__ __forceinline__ void attn_merge_phase(const DArgs& a, int half, int lane, int wave) {
    const bf16_t* QKV = (const bf16_t*)(a.ws + OFF_R);
    const float* lse = (const float*)(a.ws + OFF_LSE);
    bf16_t* Y = (bf16_t*)(a.ws + OFF_Y) + (size_t)half * 32768 * 1024;
    const int gw = a.bid * 8 + wave, NGW = a.nbk * 8;
    const int hh = lane >> 3, d0 = (lane & 7) * 16;
    for (int rl = gw; rl < 32768; rl += NGW) {
        float ls[3], mx = -1e30f;
#pragma unroll
        for (int g = 0; g < 3; ++g) { ls[g] = lse[((size_t)g * 32768 + rl) * 8 + hh]; mx = fmaxf(mx, ls[g]); }
        float w[3], ws = 0.f;
#pragma unroll
        for (int g = 0; g < 3; ++g) { w[g] = __expf(ls[g] - mx); ws += w[g]; }
        const float iws = 1.0f / ws;
        float o[16];
#pragma unroll
        for (int e = 0; e < 16; ++e) o[e] = 0.f;
#pragma unroll
        for (int g = 0; g < 3; ++g) {
            const u32x4* p = (const u32x4*)(QKV + (size_t)rl * 9216 + g * 3072 + hh * 128 + d0);
            const u32x4 x0 = p[0], x1 = p[1]; const float wg = w[g] * iws;
            const unsigned xw[8] = {x0.x, x0.y, x0.z, x0.w, x1.x, x1.y, x1.z, x1.w};
#pragma unroll
            for (int e = 0; e < 8; ++e) { o[2 * e] += wg * bflo(xw[e]); o[2 * e + 1] += wg * bfhi(xw[e]); }
        }
        u32x4* yp = (u32x4*)(Y + (size_t)rl * 1024 + hh * 128 + d0);
        yp[0] = (u32x4){pk2(o[0], o[1]), pk2(o[2], o[3]), pk2(o[4], o[5]), pk2(o[6], o[7])};
        yp[1] = (u32x4){pk2(o[8], o[9]), pk2(o[10], o[11]), pk2(o[12], o[13]), pk2(o[14], o[15])};
    }
}

#define LAS __attribute__((address_space(3)))
#define XB_TMO      128
#define XB_XCNT(j)  (256  + 64 * (j))
#define XB_XSUB(j)  (1280 + 64 * (j))
#define XB_XGEN(j)  (2304 + 64 * (j))
#define XB_TOP      3328
#define XB_TOPGEN   3392
#define XCD_BAR_WORDS 3456
#define XB_SPIN_CAP (1u << 18)

__device__ __forceinline__ unsigned xb_ld(unsigned* p)              { return __hip_atomic_load(p, __ATOMIC_RELAXED, __HIP_MEMORY_SCOPE_AGENT); }
__device__ __forceinline__ unsigned xb_add(unsigned* p, unsigned v) { return __hip_atomic_fetch_add(p, v, __ATOMIC_RELAXED, __HIP_MEMORY_SCOPE_AGENT); }
__device__ __forceinline__ unsigned xb_xcc_id() { return (unsigned)__builtin_amdgcn_s_getreg((3 << 11) | 20) & 0xFu; }
#define XB_SPIN(cond, bar) do { unsigned _sp = 0; while (cond) { __builtin_amdgcn_s_sleep(1); \
    if ((++_sp & 255u) == 0u) { if (xb_ld(&(bar)[XB_TMO])) break; if (_sp > XB_SPIN_CAP) { atomicAdd(&(bar)[XB_TMO], 1u); break; } } } } while (0)

struct XcdBarrier {
    unsigned* bar; unsigned x;
    volatile LAS unsigned* st;
};

__device__ __forceinline__ XcdBarrier xcd_barrier_post(unsigned* bar, volatile LAS unsigned* st) {
    XcdBarrier b; b.bar = bar; b.x = xb_xcc_id(); b.st = st;
    if (threadIdx.x == 0) (void)xb_add(&bar[XB_XCNT(b.x)], 1u);
    return b;
}
__device__ __forceinline__ void xcd_barrier_complete(unsigned* bar, unsigned x, unsigned& nloc, unsigned& nx) {
    const unsigned G = gridDim.x * gridDim.y * gridDim.z;
    unsigned sum, cnt, mine, sp = 0u;
    for (;;) {
        sum = 0u; cnt = 0u; mine = 0u;
#pragma unroll
        for (unsigned j = 0; j < 16; ++j) { const unsigned c = xb_ld(&bar[XB_XCNT(j)]); sum += c; cnt += (c > 0u) ? 1u : 0u; mine = (j == x) ? c : mine; }
        if (sum == G) break;
        __builtin_amdgcn_s_sleep(1);
        if ((++sp & 255u) == 0u) { if (xb_ld(&bar[XB_TMO])) break; if (sp > XB_SPIN_CAP) { atomicAdd(&bar[XB_TMO], 1u); break; } }
    }
    nloc = mine > 0u ? mine : 1u; nx = cnt > 0u ? cnt : 1u;
}

__device__ __forceinline__ void xcd_barrier(const XcdBarrier& b) {
    asm volatile("s_waitcnt vmcnt(0)" ::: "memory");
    __syncthreads();
    if (threadIdx.x == 0) {
        unsigned* bar = b.bar;
        __builtin_amdgcn_s_waitcnt(0);
        unsigned nloc = b.st[0], nx = b.st[1];
        if (nloc == 0u) { xcd_barrier_complete(bar, b.x, nloc, nx); b.st[0] = nloc; b.st[1] = nx; }
        const unsigned old = xb_add(&bar[XB_XSUB(b.x)], 1u);
        const unsigned gen = old / nloc;
        if (old + 1u == (gen + 1u) * nloc) {
            __builtin_amdgcn_fence(__ATOMIC_RELEASE, "agent");
            asm volatile("s_waitcnt vmcnt(0)" ::: "memory");
            const unsigned og = xb_add(&bar[XB_TOP], 1u);
            const unsigned tg = og / nx;
            if (og + 1u == (tg + 1u) * nx) xb_add(&bar[XB_TOPGEN], 1u);
            else XB_SPIN(xb_ld(&bar[XB_TOPGEN]) == tg, bar);
            __builtin_amdgcn_fence(__ATOMIC_ACQUIRE, "agent");
            xb_add(&bar[XB_XGEN(b.x)], 1u);
            asm volatile("s_waitcnt vmcnt(0)" ::: "memory");
        } else {
            XB_SPIN(xb_ld(&bar[XB_XGEN(b.x)]) == gen, bar);
            __builtin_amdgcn_fence(__ATOMIC_ACQUIRE, "agent");
            asm volatile("s_waitcnt vmcnt(0)" ::: "memory");
        }
    }
    __syncthreads();
}

template <class Epi> __device__ __forceinline__ void run_gemm(unsigned char* lds, const bf16_t* A, const bf16_t* Bt, int M, int N, int K, const Epi& E, int bid, int nbk) {
    pg8::Gemm g{A, Bt, M, N, K}; pg8::StaticOrder S; S.init(M, N, nbk, bid);
    pg8::gemm_phase<Epi, pg8::StaticOrder, true, true>((PG8_LAS unsigned char*)lds, g, S, E);
}
#ifndef RPT
#define RPT 0
#endif
#ifndef EN
#define EN 0xFFFF
#endif
enum { PT_P0 = 0, PT_LNMOD, PT_G1, PT_RES, PT_MPROJ, PT_MCELL, PT_QKV, PT_ATT, PT_MERGE, PT_FINAL };
constexpr int N_PHASES = 26;
__device__ __forceinline__ void phase_desc(int ph, int& type, int& l, int& s, int& x) {
    type = PT_P0; l = 0; s = 0; x = 0;
    switch (ph) {
        case 0: type = PT_P0; break;
        case 1: type = PT_LNMOD; l = 0; s = 0; break;
        case 2: type = PT_G1; l = 0; x = 0; break;
        case 3: type = PT_RES; l = 0; s = 0; break;
        case 4: type = PT_LNMOD; l = 0; s = 1; break;
        case 5: type = PT_MPROJ; break;
        case 6: type = PT_MCELL; break;
        case 7: type = PT_RES; l = 0; s = 1; break;
        case 8: type = PT_LNMOD; l = 0; s = 2; break;
        case 9: type = PT_G1; l = 0; x = 1; break;
        case 10: type = PT_RES; l = 0; s = 2; break;
        case 11: type = PT_LNMOD; l = 1; s = 0; break;
        case 12: type = PT_G1; l = 1; x = 0; break;
        case 13: type = PT_RES; l = 1; s = 0; break;
        case 14: type = PT_LNMOD; l = 1; s = 1; break;
        case 15: type = PT_QKV; x = 0; break;
        case 16: type = PT_ATT; x = 0; break;
        case 17: type = PT_MERGE; x = 0; break;
        case 18: type = PT_QKV; x = 1; break;
        case 19: type = PT_ATT; x = 1; break;
        case 20: type = PT_MERGE; x = 1; break;
        case 21: type = PT_RES; l = 1; s = 1; break;
        case 22: type = PT_LNMOD; l = 1; s = 2; break;
        case 23: type = PT_G1; l = 1; x = 1; break;
        case 24: type = PT_RES; l = 1; s = 2; break;
        default: type = PT_FINAL; break;
    }
}

__global__ void __launch_bounds__(512, 2) fwd_kernel(Args a_unused) {
#if defined(__HIP_DEVICE_COMPILE__)
    extern __shared__ __attribute__((aligned(16))) unsigned char lds[];
    cg::grid_group grid = cg::this_grid();
    typedef __attribute__((address_space(4))) const Args* KArgsPtr;
    KArgsPtr ap = (KArgsPtr)__builtin_amdgcn_kernarg_segment_ptr();
    const int ph_lo = ap->ph_lo;
    volatile LAS unsigned* bst = (volatile LAS unsigned*)(LAS unsigned char*)(lds + LDS_BYTES - 16);
    if (threadIdx.x < 4) bst[threadIdx.x] = 0u;
    __syncthreads();
    const XcdBarrier xbar = xcd_barrier_post((unsigned*)ap->ws, bst);
    for (int ph = ph_lo; ; ++ph) {
        asm volatile("" : "+s"(ap));
        DArgs a;
        { int b_ = blockIdx.x, n_ = gridDim.x; asm volatile("" : "+s"(b_), "+s"(n_)); a.bid = b_; a.nbk = n_; }
#pragma unroll
        for (int i = 0; i < 15; ++i) a.in[i] = ap->in[i];
        a.out = ap->out; a.ws = ap->ws; a.ph_lo = ap->ph_lo; a.ph_hi = ap->ph_hi;
        int tid_l = threadIdx.x; asm volatile("" : "+v"(tid_l));
        const int tid = tid_l, lane = tid & 63, wave = __builtin_amdgcn_readfirstlane(tid >> 6);
        unsigned char* ws = a.ws;
        float* mod = (float*)(ws + OFF_MOD); float* stats = (float*)(ws + OFF_STATS);
        const float* x_in = a.in[0]; const float* lng = a.in[4]; const float* lnb = a.in[5];
        float* v = a.out;
        bf16_t* H = (bf16_t*)(ws + OFF_H); bf16_t* Yb = (bf16_t*)(ws + OFF_Y); bf16_t* R = (bf16_t*)(ws + OFF_R);
        if (ph >= a.ph_hi) break;
        int type, l, s, x;
#if RPT
        { int c = 0, bp = 0;
          for (; bp < N_PHASES; ++bp) { phase_desc(bp, type, l, s, x); const int n = ((RPT >> type) & 1) ? 2 : 1; if (ph < c + n) break; c += n; } }
#else
        phase_desc(ph, type, l, s, x);
#endif
        const int q = 3 * l + s;
        const int has_ln = (q > 0) ? 1 : 0;
        const float* pg = lng + (size_t)(q > 0 ? q - 1 : 0) * DM; const float* pb = lnb + (size_t)(q > 0 ? q - 1 : 0) * DM;
        const float* vin = (q > 0) ? (const float*)v : x_in;
        const float* modl = mod + (size_t)l * 16 * NMOD;
        if (type == PT_P0 && (EN >> PT_P0 & 1)) {
            p0_phase(a, lds, tid, lane, wave);
        } else if (type == PT_LNMOD && (EN >> PT_LNMOD & 1)) {
            lnmod_phase(vin, has_ln, pg, pb, modl, s, H, stats, lane, wave, a.bid, a.nbk);
        } else if (type == PT_G1 && (EN >> PT_G1 & 1)) {
            EpiSwiGLU E{R};
            run_gemm(lds, H, (const bf16_t*)(ws + OFF_W1) + (size_t)(l * 2 + x) * 5632 * 1024, T, 5632, 1024, E, a.bid, a.nbk);
        } else if (type == PT_RES && (EN >> PT_RES & 1)) {
            const bf16_t* A; const bf16_t* Bt; int K; float wgt;
            if (s == 1) { A = Yb; Bt = (const bf16_t*)(ws + (l == 0 ? OFF_WMO : OFF_WAO)); K = 1024; wgt = 1.0f; }
            else { A = R; Bt = (const bf16_t*)(ws + OFF_W2) + (size_t)(l * 2 + (s >> 1)) * 1024 * 2816; K = 2816; wgt = 0.5f; }
            EpiResidual E{vin, v, stats, pg, pb, modl + (s * 3 + 2) * DM, wgt, has_ln};
            run_gemm(lds, A, Bt, T, 1024, K, E, a.bid, a.nbk);
        } else if (type == PT_MPROJ && (EN >> PT_MPROJ & 1)) {
            EpiStoreBf16 E{R, 3328};
            run_gemm(lds, H, (const bf16_t*)(ws + OFF_WM), T, 3328, 1024, E, a.bid, a.nbk);
        } else if (type == PT_MCELL && (EN >> PT_MCELL & 1)) {
            mlstm_phase(a, lds, tid, lane, wave);
        } else if (type == PT_QKV && (EN >> PT_QKV & 1)) {
            EpiStoreBf16 E{R, 9216};
            run_gemm(lds, H + (size_t)x * 32768 * 1024, (const bf16_t*)(ws + OFF_WA), 32768, 9216, 1024, E, a.bid, a.nbk);
        } else if (type == PT_ATT && (EN >> PT_ATT & 1)) {
            attn_phase(a, lds, tid, lane, wave);
        } else if (type == PT_MERGE && (EN >> PT_MERGE & 1)) {
            attn_merge_phase(a, x, lane, wave);
        } else {
            final_ln_phase(v, lng + 5 * DM, lnb + 5 * DM, lane, wave, a.bid, a.nbk);
        }
        asm volatile("" : "+s"(ap));
        if (ph + 1 < ap->ph_hi) { if (ph == ph_lo) grid.sync(); else xcd_barrier(xbar); }
    }
#endif
}

#ifndef MK_SPLIT
#define MK_SPLIT 0
#endif
extern "C" void kernel_launch(void* const* d_in, const int* in_sizes, int n_in, void* d_out, int out_size, void* d_ws, size_t ws_size, hipStream_t stream) {
    static int grid = 0;
    if (grid == 0) {
        if (n_in != 15 || out_size != T * DM || ws_size < WS_END) { fprintf(stderr, "kernel_launch: unexpected shapes (n_in %d out %d ws %zu)\n", n_in, out_size, ws_size); grid = -1; return; }
        int dev = 0, cus = 0, per_cu = 0;
        (void)hipGetDevice(&dev);
        (void)hipDeviceGetAttribute(&cus, hipDeviceAttributeMultiprocessorCount, dev);
        if (hipFuncSetAttribute((const void*)fwd_kernel, hipFuncAttributeMaxDynamicSharedMemorySize, LDS_BYTES) != hipSuccess) { fprintf(stderr, "kernel_launch: hipFuncSetAttribute failed\n"); grid = -1; return; }
        if (hipOccupancyMaxActiveBlocksPerMultiprocessor(&per_cu, (const void*)fwd_kernel, 512, LDS_BYTES) != hipSuccess || per_cu < 1) { fprintf(stderr, "kernel_launch: occupancy query says %d\n", per_cu); per_cu = 1; }
        (void)hipGetLastError();
        if (cus <= 0) cus = 256;
        grid = cus * 1;
    }
    if (grid < 0) return;
    if (hipMemsetAsync(d_ws, 0, 16384, stream) != hipSuccess) { fprintf(stderr, "kernel_launch: memset of the barrier words failed\n"); return; }
    Args a{};
    for (int i = 0; i < 15; ++i) a.in[i] = (const float*)d_in[i];
    a.out = (float*)d_out; a.ws = (unsigned char*)d_ws;
    a.ph_lo = 0; a.ph_hi = N_PHASES;
#if RPT
    { const int cnt[10] = {1, 6, 4, 6, 1, 1, 2, 2, 2, 1}; for (int t = 0; t < 10; ++t) if ((RPT >> t) & 1) a.ph_hi += cnt[t]; }
#endif
    void* args[] = {&a};
    hipError_t e = hipLaunchCooperativeKernel((const void*)fwd_kernel, dim3(grid), dim3(512), args, LDS_BYTES, stream);
    if (e != hipSuccess) fprintf(stderr, "kernel_launch: cooperative launch failed: %s (grid %d)\n", hipGetErrorString(e), grid);
}
```
